# Optimizing an MI355X kernel written in HIP

```python
import math
import jax, jax.numpy as jnp
from jax import lax
import numpy as np

D_MODEL = 1024
BATCH = 2
SEQ = 8192
DEPTH = 2

GRID_W = 64
CTX_LEN = 256
N_HEADS = 8
QK_NOPE = 64
QK_ROPE = 32
V_HEAD = 64
Q_LORA = 384
KV_LORA = 256
W_ATTN_IN = Q_LORA + KV_LORA + QK_ROPE
ATTN_SCALE = 1.0 / math.sqrt(QK_NOPE + QK_ROPE)
Q_BLOCK = 128
ROPE_THETA = 10000.0
FOURIER_GROUPS = 6
FOURIER_GROUP_W = 64
W_FOURIER = FOURIER_GROUPS * FOURIER_GROUP_W
SSM_GROUP_W = 16
SSM_GROUPS = 24
SSM_STATE = 64
W_SSM = SSM_GROUPS * SSM_GROUP_W
W_IN = W_ATTN_IN + W_FOURIER + W_SSM
N_BRANCH = 3
D_FF = 4 * D_MODEL
EPS = 1e-6

kernel_name = "hybrid_mla_fnet_s5_prefix_block"


def rms_norm(x, g):
    xf = x.astype(jnp.float32)
    y = xf * lax.rsqrt(jnp.mean(xf * xf, axis=-1, keepdims=True) + EPS)
    return (y * g.astype(jnp.float32)).astype(x.dtype)


def axial_rope_angles(n_tokens):
    rows = n_tokens // GRID_W
    r_ix, c_ix = jnp.meshgrid(jnp.arange(rows, dtype=jnp.float32),
                              jnp.arange(GRID_W, dtype=jnp.float32), indexing="ij")
    r_ix, c_ix = r_ix.reshape(-1), c_ix.reshape(-1)
    half = QK_ROPE // 2
    inv = ROPE_THETA ** (-jnp.arange(0, half, 2, dtype=jnp.float32) / half)
    ang = jnp.concatenate([r_ix[:, None] * inv, c_ix[:, None] * inv], axis=-1)
    return jnp.cos(ang), jnp.sin(ang)


def apply_rope(x, cos, sin):
    h = QK_ROPE // 2
    x1, x2 = x[..., :h], x[..., h:]
    cos, sin = cos.astype(x.dtype), sin.astype(x.dtype)
    return jnp.concatenate([x1 * cos - x2 * sin, x2 * cos + x1 * sin], axis=-1)


def mla_q(z_a, q_norm, w_uq):
    bsz, n, _ = z_a.shape
    q = (rms_norm(z_a[..., :Q_LORA], q_norm) @ w_uq).reshape(bsz, n, N_HEADS, QK_NOPE + QK_ROPE)
    return q[..., :QK_NOPE], q[..., QK_NOPE:]


def mla_kv(z_a, kv_norm, w_ukv):
    bsz, n, _ = z_a.shape
    c_kv = rms_norm(z_a[..., Q_LORA:Q_LORA + KV_LORA], kv_norm)
    kv = (c_kv @ w_ukv).reshape(bsz, n, N_HEADS, QK_NOPE + V_HEAD)
    k_rope = z_a[..., Q_LORA + KV_LORA:]
    return kv[..., :QK_NOPE], kv[..., QK_NOPE:], k_rope


def attend(q_nope, q_rope, k_nope, k_rope, v):
    s = jnp.einsum('bqhd,bkhd->bhqk', q_nope, k_nope, preferred_element_type=jnp.float32)
    s = s + jnp.einsum('bqhr,bkr->bhqk', q_rope, k_rope, preferred_element_type=jnp.float32)
    p = jax.nn.softmax(s * ATTN_SCALE, axis=-1).astype(v.dtype)
    return jnp.einsum('bhqk,bkhd->bqhd', p, v)


def latent_attention(q_nope, q_rope, k_nope, k_rope, v):
    bsz, n, h, _ = q_nope.shape
    nb = n // Q_BLOCK
    qn = q_nope.reshape(bsz, nb, Q_BLOCK, h, QK_NOPE).transpose(1, 0, 2, 3, 4)
    qr = q_rope.reshape(bsz, nb, Q_BLOCK, h, QK_ROPE).transpose(1, 0, 2, 3, 4)
    o = lax.map(lambda a: attend(a[0], a[1], k_nope, k_rope, v), (qn, qr))
    return o.transpose(1, 0, 2, 3, 4).reshape(bsz, n, h * V_HEAD)


def fourier_mix(z):
    bsz, n, _ = z.shape
    u = z.astype(jnp.float32).reshape(bsz, n, FOURIER_GROUPS, FOURIER_GROUP_W)
    y = jnp.fft.fftn(u, axes=(1, 3), norm="ortho").real
    return y.reshape(bsz, n, W_FOURIER).astype(z.dtype)


def s5_discretize(a_re, a_im, log_step, b_re, b_im):
    a = lax.complex(a_re.astype(jnp.float32), a_im.astype(jnp.float32))
    dt = jnp.exp(log_step.astype(jnp.float32))[..., None]
    a_bar = jnp.exp(dt * a)
    b = lax.complex(b_re.astype(jnp.float32), b_im.astype(jnp.float32))
    b_bar = ((a_bar - 1.0) / a)[..., None] * b
    return a_bar, b_bar


def _ssm_combine(left, right):
    a_l, b_l = left
    a_r, b_r = right
    return a_l * a_r, a_r * b_l + b_r


def ssm_scan(a_bar, bu, init, reverse):
    if init is not None:
        idx = -1 if reverse else 0
        bu = bu.at[:, idx].add(a_bar * init)
    a = jnp.broadcast_to(a_bar, (1,) + bu.shape[1:])
    _, s = lax.associative_scan(_ssm_combine, (a, bu), reverse=reverse, axis=1)
    return s


def s5_states(z, a_bar, b_bar, init_f, init_b):
    bsz, n, _ = z.shape
    u = z.astype(jnp.float32).reshape(bsz, n, SSM_GROUPS, SSM_GROUP_W)
    s_f = ssm_scan(a_bar[0], jnp.einsum('blgp,gnp->blgn', u, b_bar[0]), init_f, reverse=False)
    s_b = ssm_scan(a_bar[1], jnp.einsum('blgp,gnp->blgn', u, b_bar[1]), init_b, reverse=True)
    return s_f, s_b


def s5_readout(z, s_f, s_b, c_re, c_im, d, w_glu, b_glu):
    bsz, n, _ = z.shape
    cmat = lax.complex(c_re.astype(jnp.float32), c_im.astype(jnp.float32))
    y = (jnp.einsum('blgn,gpn->blgp', s_f, cmat[0]) + jnp.einsum('blgn,gpn->blgp', s_b, cmat[1])).real
    y = y.reshape(bsz, n, W_SSM) + d.astype(jnp.float32) * z.astype(jnp.float32)
    y = jax.nn.gelu(y).astype(z.dtype)
    return y * jax.nn.sigmoid(y @ w_glu + b_glu)


def merge_branches(h, o_attn, o_f, o_s, lp):
    g = jax.nn.sigmoid(h @ lp["w_gate"] + lp["b_gate"])
    g_a, g_f, g_s = jnp.split(g, N_BRANCH, axis=-1)
    m = (g_a * (o_attn @ lp["w_br_attn"]) + g_f * (o_f @ lp["w_br_fourier"])
         + g_s * (o_s @ lp["w_br_ssm"]))
    return m @ lp["w_out"]


def sq_relu_mlp(h, lp):
    return jnp.square(jax.nn.relu(h @ lp["w_mlp1"])) @ lp["w_mlp2"]


def hybrid_layer(x, xc, ada_lat, ada_ctx, lp, update_ctx):
    bsz, n, _ = x.shape
    sh1, sc1, g1, sh2, sc2, g2 = jnp.split(ada_lat[:, None, :], 6, axis=-1)
    csh1, csc1, cg1, csh2, csc2, cg2 = jnp.split(ada_ctx, 6)
    h = rms_norm(x, lp["ln1"]) * (1.0 + sc1) + sh1
    hc = rms_norm(xc, lp["ln1"]) * (1.0 + csc1) + csh1
    w_in = lp["w_in"]
    f0, s0 = W_ATTN_IN, W_ATTN_IN + W_FOURIER
    z = h @ w_in
    za, zf, zs = z[..., :f0], z[..., f0:s0], z[..., s0:]
    zca = hc @ w_in[:, :f0]
    zcs = hc @ w_in[:, s0:]

    cos, sin = axial_rope_angles(n)
    qn, qr = mla_q(za, lp["q_norm"], lp["w_uq"])
    qr = apply_rope(qr, cos[:, None, :], sin[:, None, :])
    kn, v, kr = mla_kv(za, lp["kv_norm"], lp["w_ukv"])
    kr = apply_rope(kr, cos, sin)
    ckn, cv, ckr = mla_kv(zca, lp["kv_norm"], lp["w_ukv"])
    o_attn = latent_attention(qn, qr, jnp.concatenate([ckn, kn], axis=1),
                              jnp.concatenate([ckr, kr], axis=1), jnp.concatenate([cv, v], axis=1))

    o_f = fourier_mix(zf)

    a_bar, b_bar = s5_discretize(lp["ssm_a_re"], lp["ssm_a_im"], lp["ssm_log_step"],
                                 lp["ssm_b_re"], lp["ssm_b_im"])
    cs_f, cs_b = s5_states(zcs, a_bar, b_bar, None, None)
    s_f, s_b = s5_states(zs, a_bar, b_bar, cs_f[:, -1], cs_b[:, 0])
    o_s = s5_readout(zs, s_f, s_b, lp["ssm_c_re"], lp["ssm_c_im"], lp["ssm_d"], lp["w_glu"], lp["b_glu"])

    x = x + g1 * merge_branches(h, o_attn, o_f, o_s, lp)
    x = x + g2 * sq_relu_mlp(rms_norm(x, lp["ln2"]) * (1.0 + sc2) + sh2, lp)

    if update_ctx:
        lc = xc.shape[1]
        cqn, cqr = mla_q(zca, lp["q_norm"], lp["w_uq"])
        co_attn = attend(cqn, cqr, ckn, ckr, cv).reshape(bsz, lc, N_HEADS * V_HEAD)
        co_f = fourier_mix(hc @ w_in[:, f0:s0])
        co_s = s5_readout(zcs, cs_f, cs_b, lp["ssm_c_re"], lp["ssm_c_im"], lp["ssm_d"],
                          lp["w_glu"], lp["b_glu"])
        xc = xc + cg1 * merge_branches(hc, co_attn, co_f, co_s, lp)
        xc = xc + cg2 * sq_relu_mlp(rms_norm(xc, lp["ln2"]) * (1.0 + csc2) + csh2, lp)
    return x, xc


def setup_inputs(seed: int = 0) -> dict:
    key = jax.random.key(seed)
    ks = iter(jax.random.split(key, 40))
    f32 = jnp.float32

    def nrm(shape, scale):
        return jax.random.normal(next(ks), shape, f32) * scale

    def gain(shape):
        return 1.0 + 0.02 * jax.random.normal(next(ks), shape, f32)

    L = DEPTH
    n_idx = jnp.arange(SSM_STATE, dtype=f32)
    return {
        "x": nrm((BATCH, SEQ, D_MODEL), 1.0),
        "c": nrm((BATCH, D_MODEL), 1.0),
        "ctx": nrm((BATCH, CTX_LEN, D_MODEL), 1.0),
        "c_ctx": nrm((D_MODEL,), 1.0),
        "ada_w": nrm((L, D_MODEL, 6 * D_MODEL), D_MODEL ** -0.5),
        "ada_b": nrm((L, 6 * D_MODEL), 0.02),
        "ln1": gain((L, D_MODEL)),
        "ln2": gain((L, D_MODEL)),
        "w_in": nrm((L, D_MODEL, W_IN), D_MODEL ** -0.5),
        "q_norm": gain((L, Q_LORA)),
        "w_uq": nrm((L, Q_LORA, N_HEADS * (QK_NOPE + QK_ROPE)), Q_LORA ** -0.5),
        "kv_norm": gain((L, KV_LORA)),
        "w_ukv": nrm((L, KV_LORA, N_HEADS * (QK_NOPE + V_HEAD)), KV_LORA ** -0.5),
        "ssm_a_re": -0.5 + nrm((L, 2, SSM_GROUPS, SSM_STATE), 0.01),
        "ssm_a_im": jnp.pi * n_idx + nrm((L, 2, SSM_GROUPS, SSM_STATE), 0.01),
        "ssm_log_step": jax.random.uniform(next(ks), (L, 2, SSM_GROUPS), f32,
                                           minval=math.log(1e-3), maxval=math.log(1e-1)),
        "ssm_b_re": nrm((L, 2, SSM_GROUPS, SSM_STATE, SSM_GROUP_W), (2 * SSM_GROUP_W) ** -0.5),
        "ssm_b_im": nrm((L, 2, SSM_GROUPS, SSM_STATE, SSM_GROUP_W), (2 * SSM_GROUP_W) ** -0.5),
        "ssm_c_re": nrm((L, 2, SSM_GROUPS, SSM_GROUP_W, SSM_STATE), 0.5),
        "ssm_c_im": nrm((L, 2, SSM_GROUPS, SSM_GROUP_W, SSM_STATE), 0.5),
        "ssm_d": nrm((L, W_SSM), 1.0),
        "w_glu": nrm((L, W_SSM, W_SSM), W_SSM ** -0.5),
        "b_glu": nrm((L, W_SSM), 0.02),
        "w_br_attn": nrm((L, N_HEADS * V_HEAD, D_MODEL), (N_HEADS * V_HEAD) ** -0.5),
        "w_br_fourier": nrm((L, W_FOURIER, D_MODEL), W_FOURIER ** -0.5),
        "w_br_ssm": nrm((L, W_SSM, D_MODEL), W_SSM ** -0.5),
        "w_gate": nrm((L, D_MODEL, N_BRANCH * D_MODEL), D_MODEL ** -0.5),
        "b_gate": nrm((L, N_BRANCH * D_MODEL), 0.02),
        "w_out": nrm((L, D_MODEL, D_MODEL), D_MODEL ** -0.5),
        "w_mlp1": nrm((L, D_MODEL, D_FF), D_MODEL ** -0.5),
        "w_mlp2": nrm((L, D_FF, D_MODEL), D_FF ** -0.5),
        "final_norm": gain((D_MODEL,)),
    }


def reference(x, c, ctx, c_ctx, ada_w, ada_b, ln1, ln2, w_in, q_norm, w_uq, kv_norm, w_ukv,
              ssm_a_re, ssm_a_im, ssm_log_step, ssm_b_re, ssm_b_im, ssm_c_re, ssm_c_im, ssm_d,
              w_glu, b_glu, w_br_attn, w_br_fourier, w_br_ssm, w_gate, b_gate, w_out,
              w_mlp1, w_mlp2, final_norm):
    xc = ctx
    silu_c = jax.nn.silu(c)
    silu_cc = jax.nn.silu(c_ctx)
    for l in range(DEPTH):
        ada_lat = silu_c @ ada_w[l] + ada_b[l]
        ada_ctx = silu_cc @ ada_w[l] + ada_b[l]
        lp = dict(ln1=ln1[l], ln2=ln2[l], w_in=w_in[l], q_norm=q_norm[l], w_uq=w_uq[l],
                  kv_norm=kv_norm[l], w_ukv=w_ukv[l], ssm_a_re=ssm_a_re[l], ssm_a_im=ssm_a_im[l],
                  ssm_log_step=ssm_log_step[l], ssm_b_re=ssm_b_re[l], ssm_b_im=ssm_b_im[l],
                  ssm_c_re=ssm_c_re[l], ssm_c_im=ssm_c_im[l], ssm_d=ssm_d[l], w_glu=w_glu[l],
                  b_glu=b_glu[l], w_br_attn=w_br_attn[l], w_br_fourier=w_br_fourier[l],
                  w_br_ssm=w_br_ssm[l], w_gate=w_gate[l], b_gate=b_gate[l], w_out=w_out[l],
                  w_mlp1=w_mlp1[l], w_mlp2=w_mlp2[l])
        x, xc = hybrid_layer(x, xc, ada_lat, ada_ctx, lp, update_ctx=(l < DEPTH - 1))
    return rms_norm(x, final_norm)
```

```cpp
#include <hip/hip_runtime.h>
#include <hip/hip_cooperative_groups.h>
#include <stdint.h>
#include <stdio.h>
namespace cg = cooperative_groups;

#ifndef MULTI_LAUNCH
#define MULTI_LAUNCH 0
#endif

typedef unsigned short bf16_t;
typedef short bf16x8 __attribute__((ext_vector_type(8)));
typedef float f32x4 __attribute__((ext_vector_type(4)));
typedef unsigned u32x4 __attribute__((ext_vector_type(4)));
#define DI __device__ __forceinline__
#define BID_ ({ int z_ = 0; asm volatile("" : "+s"(z_)); (int)blockIdx.x * 2 + HALF_ + z_; })
#define GDIM_ ({ int z_ = 0; asm volatile("" : "+s"(z_)); (int)gridDim.x * 2 + z_; })
#define HALF_ ({ int zh_ = 0; asm volatile("" : "+s"(zh_)); (int)__builtin_amdgcn_readfirstlane((int)(threadIdx.x >> 8) + zh_); })
#define TID_ ({ int z_ = 0; asm volatile("" : "+s"(z_)); (int)(threadIdx.x & 255) + z_; })
#define TID8_ ({ int z_ = 0; asm volatile("" : "+s"(z_)); (int)threadIdx.x + z_; })
#define PBID_ ({ int z_ = 0; asm volatile("" : "+s"(z_)); (int)blockIdx.x + z_; })
#define PGDIM_ ({ int z_ = 0; asm volatile("" : "+s"(z_)); (int)gridDim.x + z_; })
#define MFMA16(a, b, c) __builtin_amdgcn_mfma_f32_16x16x32_bf16((a), (b), (c), 0, 0, 0)

constexpr int TPB = 8448, R = 16896, SEQ = 8192, CTX = 256;
constexpr int NPH_LAYER = 14, NPH = 2 * NPH_LAYER + 1;
constexpr size_t al256(size_t x) { return (x + 255) & ~(size_t)255; }
constexpr int LD1 = 1088, LD4 = 4160;
constexpr size_t WO_IN = 0, WO_GATE = WO_IN + 1440 * LD1, WO_UQ = WO_GATE + 3072 * LD1, WO_K = WO_UQ + 768 * 384,
                 WO_V = WO_K + 512 * 256, WO_GLU = WO_V + 512 * 256, WO_BA = WO_GLU + 384 * 384, WO_BF = WO_BA + 1024 * 512,
                 WO_BS = WO_BF + 1024 * 384, WO_OUT = WO_BS + 1024 * 384, WO_1 = WO_OUT + 1024 * LD1, WO_2 = WO_1 + 4096 * LD1,
                 WO_END = WO_2 + 1024 * LD4;
constexpr size_t OFF_H = 0;
constexpr size_t OFF_W = OFF_H + (size_t)R * LD1 * 2;
constexpr size_t OFF_XC = OFF_W + WO_END * 2;
constexpr size_t OFF_MOD = OFF_XC + 512 * 1024 * 4;
constexpr size_t OFF_ROPE = OFF_MOD + al256(2 * 3 * 6144 * 4);
constexpr size_t OFF_TW8192 = OFF_ROPE + 2 * 8192 * 16 * 4;
constexpr size_t OFF_TW256 = OFF_TW8192 + 8192 * 2 * 4;
constexpr size_t OFF_T0 = OFF_TW256 + 256 * 2 * 4;
constexpr size_t OFF_T1L = OFF_T0 + 128 * 64 * 2;
constexpr size_t OFF_T1C = OFF_T1L + 256 * 256 * 2;
constexpr size_t OFF_T2L = OFF_T1C + 32 * 32 * 2;
constexpr size_t OFF_T2C = OFF_T2L + 64 * 128 * 2;
constexpr size_t OFF_ABAR = OFF_T2C + 16 * 32 * 2;
constexpr size_t OFF_A64 = OFF_ABAR + 2 * 24 * 64 * 2 * 4;
constexpr size_t OFF_BBAR = OFF_A64 + 2 * 24 * 64 * 2 * 4;
constexpr size_t OFF_CXT = OFF_BBAR + 2 * 24 * 64 * 32 * 4;
constexpr size_t OFF_Z = al256(OFF_CXT + 2 * 24 * 16 * 128 * 2);
constexpr size_t OFF_T = OFF_Z + (size_t)R * 1440 * 2;
constexpr size_t SZ_T = 25952256;
constexpr size_t OFF_Q = OFF_T + SZ_T;
constexpr size_t OFF_K = OFF_Q + (size_t)R * 768 * 2;
constexpr size_t OFF_VT = OFF_K + (size_t)R * 768 * 2;
constexpr size_t OFF_OA = OFF_VT + (size_t)2 * 8 * 64 * TPB * 2;
constexpr size_t OFF_OF = OFF_OA + (size_t)R * 512 * 2;
constexpr size_t OFF_OS = OFF_OF + (size_t)R * 384 * 2;
constexpr size_t OFF_END = OFF_OS + (size_t)R * 384 * 2;
constexpr size_t OFF_BAR = OFF_END;
static_assert(OFF_BAR + 16384 <= 268435456, "workspace too large");
constexpr size_t T_QIN = 0, T_CKV = (size_t)R * 384 * 2;
constexpr size_t T_F1L = 0, T_F1C = (size_t)2 * 8192 * 768 * 2;
constexpr size_t T_SEND = 0, T_CARRY = (size_t)2 * 2 * 24 * 132 * 64 * 2 * 4, T_YG = 2 * T_CARRY;
static_assert(T_YG + (size_t)R * 384 * 2 <= SZ_T && T_F1C + (size_t)2 * 256 * 768 * 2 <= SZ_T, "T region");
static_assert((size_t)R * LD4 * 2 <= OFF_OA - OFF_Z, "U alias");

constexpr int SMEM_HALF = 69632, SMEM_BYTES = 2 * SMEM_HALF;

struct Params { const float* in[32]; float* out; char* ws; int lo, hi; };

DI bf16_t f2bf(float x) { unsigned u = __float_as_uint(x); u += 0x7fffu + ((u >> 16) & 1u); return (bf16_t)(u >> 16); }
DI float bf2f(bf16_t h) { return __uint_as_float(((unsigned)h) << 16); }
typedef __bf16 bf2_t __attribute__((ext_vector_type(2)));
typedef float f2_t __attribute__((ext_vector_type(2)));
DI unsigned pack2(float a, float b) { f2_t v = {a, b}; bf2_t r = __builtin_convertvector(v, bf2_t); return __builtin_bit_cast(unsigned, r); }
DI float bflo(unsigned w) { return __uint_as_float(w << 16); }
DI float bfhi(unsigned w) { return __uint_as_float(w & 0xffff0000u); }
DI float max3f(float a, float b, float c) { float r; asm("v_max3_f32 %0, %1, %2, %3" : "=v"(r) : "v"(a), "v"(b), "v"(c)); return r; }
DI float sigmoidf_(float x) { return 1.f / (1.f + __expf(-x)); }
DI float shx(float v, int mask) {
    unsigned z_ = 0; asm volatile("" : "+s"(z_));
    const int lane = (int)__builtin_amdgcn_mbcnt_hi(~0u, __builtin_amdgcn_mbcnt_lo(~0u, z_));
    return __int_as_float(__builtin_amdgcn_ds_bpermute((lane ^ mask) << 2, __float_as_int(v)));
}
DI float wave_sum(float v) {
#pragma unroll
    for (int o = 32; o >= 1; o >>= 1) v += shx(v, o);
    return v;
}
DI float* xptr(const Params& p, bool orig, int row) {
    const int b = row / TPB, t = row - b * TPB;
    if (t < CTX) { float* base = orig ? (float*)p.in[2] : (float*)(p.ws + OFF_XC); return base + (size_t)(b * CTX + t) * 1024; }
    float* base = orig ? (float*)p.in[0] : p.out; return base + (size_t)(b * SEQ + t - CTX) * 1024;
}
DI int srow_of(int row) { const int b = row / TPB, t = row - b * TPB; return t < CTX ? 2 : b; }

DI void gemm_main(f32x4 (&acc)[4][4], const bf16_t* __restrict__ A, int lda, int arows, const bf16_t* __restrict__ B, int ldb, int brows,
                  int K, int row0, int col0, char* smem) {
    const int tid = TID_, lane = tid & 63, wave = tid >> 6, l15 = lane & 15, quad = lane >> 4, wm = wave >> 1, wn = wave & 1;
    __builtin_amdgcn_sched_barrier(0);
    char* As = smem;
    char* Bs = smem + 32768;
#pragma unroll
    for (int i = 0; i < 4; ++i)
#pragma unroll
        for (int j = 0; j < 4; ++j) acc[i][j] = (f32x4){0.f, 0.f, 0.f, 0.f};
    const int sb = lane * 16, swz = sb ^ (((sb >> 9) & 1) << 5), sr = swz >> 6, sk = (swz & 63) >> 1;
    const bf16_t* pa[4]; const bf16_t* pb[4];
#pragma unroll
    for (int i = 0; i < 4; ++i) {
        const int st = wave + 4 * i, rr = (st >> 1) * 16 + sr, kk = (st & 1) * 32 + sk;
        pa[i] = A + (size_t)min(row0 + rr, arows - 1) * lda + kk;
        pb[i] = B + (size_t)min(col0 + rr, brows - 1) * ldb + kk;
    }
    const int wofs = wave * 1024 + lane * 16;
    const int lo = (l15 * 64 + quad * 16) ^ ((l15 >> 3) << 5);
    u32x4 ra[4], rb[4];
#define G_ISSUE(k0) _Pragma("unroll") for (int i = 0; i < 4; ++i) { ra[i] = *(const u32x4*)(pa[i] + (k0)); rb[i] = *(const u32x4*)(pb[i] + (k0)); }
#define G_WRITE(buf) _Pragma("unroll") for (int i = 0; i < 4; ++i) { *(u32x4*)(As + (buf)*16384 + i * 4096 + wofs) = ra[i]; *(u32x4*)(Bs + (buf)*16384 + i * 4096 + wofs) = rb[i]; }
    const int KT = K >> 6;
    G_ISSUE(0)
    G_WRITE(0)
    if (KT > 1) { G_ISSUE(64) }
    __syncthreads();
    for (int kt = 0; kt < KT; ++kt) {
        const int cur = kt & 1;
#pragma unroll
        for (int ks = 0; ks < 2; ++ks) {
            if (ks == 1) {
                if (kt + 1 < KT) { G_WRITE(cur ^ 1) }
                if (kt + 2 < KT) { G_ISSUE((kt + 2) * 64) }
            }
            bf16x8 af[4], bfr[4];
#pragma unroll
            for (int mi = 0; mi < 4; ++mi) af[mi] = *(const bf16x8*)(As + cur * 16384 + ((wm * 4 + mi) * 2 + ks) * 1024 + lo);
#pragma unroll
            for (int ni = 0; ni < 4; ++ni) bfr[ni] = *(const bf16x8*)(Bs + cur * 16384 + ((wn * 4 + ni) * 2 + ks) * 1024 + lo);
#pragma unroll
            for (int mi = 0; mi < 4; ++mi)
#pragma unroll
                for (int ni = 0; ni < 4; ++ni) acc[mi][ni] = MFMA16(bfr[ni], af[mi], acc[mi][ni]);
            __builtin_amdgcn_sched_barrier(0);
        }
        __syncthreads();
    }
#undef G_ISSUE
#undef G_WRITE
}
DI void gemm_main2(f32x4 (&acc)[8][4], const bf16_t* __restrict__ A, int lda, int arows, const bf16_t* __restrict__ B, int ldb, int brows,
                   int K, int row0, int col0, char* smem) {
    const int tid = TID_, lane = tid & 63, wave = tid >> 6, l15 = lane & 15, quad = lane >> 4, wm = wave >> 1, wn = wave & 1;
    __builtin_amdgcn_sched_barrier(0);
    char* As = smem;
    char* Bs = smem + 32768;
#pragma unroll
    for (int i = 0; i < 8; ++i)
#pragma unroll
        for (int j = 0; j < 4; ++j) acc[i][j] = (f32x4){0.f, 0.f, 0.f, 0.f};
    const int sb = lane * 16, swz = sb ^ (((sb >> 9) & 1) << 5), sr = swz >> 6, sk = (swz & 63) >> 1;
    const bf16_t* pa[4]; const bf16_t* pb[2];
#pragma unroll
    for (int i = 0; i < 4; ++i) pa[i] = A + (size_t)min(row0 + (wave + 4 * i) * 16 + sr, arows - 1) * lda + sk;
#pragma unroll
    for (int i = 0; i < 2; ++i) pb[i] = B + (size_t)min(col0 + (wave + 4 * i) * 16 + sr, brows - 1) * ldb + sk;
    const int wofs = wave * 1024 + lane * 16;
    const int lo = (l15 * 64 + quad * 16) ^ ((l15 >> 3) << 5);
    u32x4 ra[4], rb[2];
#define G_ISSUE(k0) { _Pragma("unroll") for (int i = 0; i < 4; ++i) ra[i] = *(const u32x4*)(pa[i] + (k0)); _Pragma("unroll") for (int i = 0; i < 2; ++i) rb[i] = *(const u32x4*)(pb[i] + (k0)); }
#define G_WRITE(buf) { _Pragma("unroll") for (int i = 0; i < 4; ++i) *(u32x4*)(As + (buf)*16384 + i * 4096 + wofs) = ra[i]; _Pragma("unroll") for (int i = 0; i < 2; ++i) *(u32x4*)(Bs + (buf)*8192 + i * 4096 + wofs) = rb[i]; }
    const int KT = K >> 5;
    G_ISSUE(0)
    G_WRITE(0)
    if (KT > 1) G_ISSUE(32)
    __syncthreads();
    for (int kt = 0; kt < KT; ++kt) {
        const int cur = kt & 1;
        bf16x8 bfr[4];
#pragma unroll
        for (int ni = 0; ni < 4; ++ni) bfr[ni] = *(const bf16x8*)(Bs + cur * 8192 + (wn * 4 + ni) * 1024 + lo);
#pragma unroll
        for (int mi = 0; mi < 4; ++mi) {
            const bf16x8 af = *(const bf16x8*)(As + cur * 16384 + (wm * 8 + mi) * 1024 + lo);
#pragma unroll
            for (int ni = 0; ni < 4; ++ni) acc[mi][ni] = MFMA16(bfr[ni], af, acc[mi][ni]);
        }
        __builtin_amdgcn_sched_barrier(0);
        if (kt + 1 < KT) G_WRITE(cur ^ 1)
        if (kt + 2 < KT) G_ISSUE((kt + 2) * 32)
#pragma unroll
        for (int mi = 4; mi < 8; ++mi) {
            const bf16x8 af = *(const bf16x8*)(As + cur * 16384 + (wm * 8 + mi) * 1024 + lo);
#pragma unroll
            for (int ni = 0; ni < 4; ++ni) acc[mi][ni] = MFMA16(bfr[ni], af, acc[mi][ni]);
        }
        __syncthreads();
    }
#undef G_ISSUE
#undef G_WRITE
}
#define EPI2_ROW(mi) (row0 + wm_ * 128 + (mi)*16 + l15_)
DI void gemm_main3(f32x4 (&acc)[8][4], const bf16_t* __restrict__ A, int lda, int arows, const bf16_t* __restrict__ B, int ldb, int brows,
                   int K, int row0, int col0, char* smem8) {
    const int tid = TID8_, lane = tid & 63, wave = tid >> 6, l15 = lane & 15, quad = lane >> 4, wr = wave >> 2, wc = wave & 3;
    __builtin_amdgcn_sched_barrier(0);
    char* As = smem8;
    char* Bs = smem8 + 65536;
#pragma unroll
    for (int i = 0; i < 8; ++i)
#pragma unroll
        for (int j = 0; j < 4; ++j) acc[i][j] = (f32x4){0.f, 0.f, 0.f, 0.f};
    const int sb = lane * 16, swz = sb ^ (((sb >> 9) & 1) << 5), sr = swz >> 6, sk = (swz & 63) >> 1;
    const bf16_t* pa[4]; const bf16_t* pb[4];
#pragma unroll
    for (int i = 0; i < 4; ++i) {
        const int st = wave + 8 * i, rr = (st >> 1) * 16 + sr, kk = (st & 1) * 32 + sk;
        pa[i] = A + (size_t)min(row0 + rr, arows - 1) * lda + kk;
        pb[i] = B + (size_t)min(col0 + rr, brows - 1) * ldb + kk;
    }
    const int wofs = wave * 1024 + lane * 16;
    const int lo = (l15 * 64 + quad * 16) ^ ((l15 >> 3) << 5);
    u32x4 ra[4], rb[4];
#define G_ISSUE(k0) { _Pragma("unroll") for (int i = 0; i < 4; ++i) { ra[i] = *(const u32x4*)(pa[i] + (k0)); rb[i] = *(const u32x4*)(pb[i] + (k0)); } }
#define G_WRITE(buf) { _Pragma("unroll") for (int i = 0; i < 4; ++i) { *(u32x4*)(As + (buf)*32768 + i * 8192 + wofs) = ra[i]; *(u32x4*)(Bs + (buf)*32768 + i * 8192 + wofs) = rb[i]; } }
    const int KT = K >> 6;
    G_ISSUE(0)
    G_WRITE(0)
    if (KT > 1) G_ISSUE(64)
    __syncthreads();
    for (int kt = 0; kt < KT; ++kt) {
        const int cur = kt & 1;
#pragma unroll
        for (int ks = 0; ks < 2; ++ks) {
            if (ks == 1) {
                if (kt + 1 < KT) G_WRITE(cur ^ 1)
                if (kt + 2 < KT) G_ISSUE((kt + 2) * 64)
            }
            bf16x8 bfr[4];
#pragma unroll
            for (int ni = 0; ni < 4; ++ni) bfr[ni] = *(const bf16x8*)(Bs + cur * 32768 + ((wc * 4 + ni) * 2 + ks) * 1024 + lo);
#pragma unroll
            for (int mi = 0; mi < 8; ++mi) {
                const bf16x8 af = *(const bf16x8*)(As + cur * 32768 + ((wr * 8 + mi) * 2 + ks) * 1024 + lo);
#pragma unroll
                for (int ni = 0; ni < 4; ++ni) acc[mi][ni] = MFMA16(bfr[ni], af, acc[mi][ni]);
            }
            __builtin_amdgcn_sched_barrier(0);
        }
        __syncthreads();
    }
#undef G_ISSUE
#undef G_WRITE
}
#define EPI8_VARS const int tid8_ = TID8_, lane8_ = tid8_ & 63, wave8_ = tid8_ >> 6, l15e_ = lane8_ & 15, quade_ = lane8_ >> 4, wr_ = wave8_ >> 2, wc_ = wave8_ & 3;
#define EPI8_ROW(mi) (row0 + wr_ * 128 + (mi)*16 + l15e_)
#define EPI8_COL(ni) (col0 + wc_ * 64 + (ni)*16 + quade_ * 4)
#define EPI_VARS const int tid_ = TID_, lane_ = tid_ & 63, wave_ = tid_ >> 6, l15_ = lane_ & 15, quad_ = lane_ >> 4, wm_ = wave_ >> 1, wn_ = wave_ & 1; (void)l15_; (void)quad_; (void)wm_; (void)wn_;
#define EPI_ROW(mi) (row0 + wm_ * 64 + (mi)*16 + l15_)
#define EPI_COL(ni) (col0 + wn_ * 64 + (ni)*16 + quad_ * 4)
DI void st_bf4(bf16_t* dst, float a, float b, float c, float d) { uint2 w; w.x = pack2(a, b); w.y = pack2(c, d); *(uint2*)dst = w; }
template <int MI>
DI void stage_tile_bf16(const f32x4 (&acc)[MI][4], char* smem, bf16_t* __restrict__ dst, int ld, int row0, int col0, int ncols, bool kmap = false) {
    const int tid = TID_, lane = tid & 63, wave = tid >> 6, l15 = lane & 15, quad = lane >> 4, wm = wave >> 1, wn = wave & 1;
    bf16_t* T = (bf16_t*)smem;
#pragma unroll
    for (int mi = 0; mi < MI; ++mi)
#pragma unroll
        for (int ni = 0; ni < 4; ++ni) {
            uint2 w; w.x = pack2(acc[mi][ni][0], acc[mi][ni][1]); w.y = pack2(acc[mi][ni][2], acc[mi][ni][3]);
            *(uint2*)&T[(wm * (MI * 16) + mi * 16 + l15) * 136 + wn * 64 + ni * 16 + quad * 4] = w;
        }
    __syncthreads();
#pragma unroll
    for (int i = 0; i < MI * 2; ++i) {
        const int c = tid + 256 * i, r = c >> 4, part = c & 15;
        const int cc_ = col0 + part * 8, dc_ = kmap ? (cc_ >> 6) * 96 + (cc_ & 63) : cc_;
        if (cc_ < ncols) *(u32x4*)(dst + (size_t)(row0 + r) * ld + dc_) = *(const u32x4*)&T[r * 136 + part * 8];
    }
    __syncthreads();
}

DI void stage_tile8(const f32x4 (&acc)[8][4], char* smem8, bf16_t* __restrict__ dst, int ld, int row0, int col0, int ncols) {
    const int tid = TID8_, lane = tid & 63, wave = tid >> 6, l15 = lane & 15, quad = lane >> 4, wr = wave >> 2, wc = wave & 3;
    bf16_t* T = (bf16_t*)smem8;
#pragma unroll
    for (int mi = 0; mi < 8; ++mi)
#pragma unroll
        for (int ni = 0; ni < 4; ++ni) {
            uint2 w; w.x = pack2(acc[mi][ni][0], acc[mi][ni][1]); w.y = pack2(acc[mi][ni][2], acc[mi][ni][3]);
            *(uint2*)&T[(wr * 128 + mi * 16 + l15) * 264 + wc * 64 + ni * 16 + quad * 4] = w;
        }
    __syncthreads();
#pragma unroll
    for (int i = 0; i < 16; ++i) {
        const int c = tid + 512 * i, r = c >> 5, part = c & 31;
        if (col0 + part * 8 < ncols) *(u32x4*)(dst + (size_t)(row0 + r) * ld + col0 + part * 8) = *(const u32x4*)&T[r * 264 + part * 8];
    }
    __syncthreads();
}
DI void conv_job(const float* __restrict__ W, int K, int N, int ldw, int mode, bf16_t* __restrict__ Wt, int ldo, char* smem) {
    const int tid = TID_;
    bf16_t* T = (bf16_t*)smem;
    const int tn = N >> 5, ntiles = (K >> 6) * tn;
    const int kk = tid >> 3, n4 = (tid & 7) * 4;
    const int bid = BID_, gstep = GDIM_;
    f32x4 v0 = {0.f, 0.f, 0.f, 0.f}, v1 = v0;
    auto src_of = [&](int t) -> const float* {
        const int k0 = (t / tn) * 64, nn = (t % tn) * 32 + n4;
        const int sc = mode == 0 ? nn : ((nn >> 6) * 128 + (nn & 63) + (mode == 2 ? 64 : 0));
        return W + (size_t)(k0 + kk) * ldw + sc;
    };
    if (bid < ntiles) { const float* sp = src_of(bid); v0 = *(const f32x4*)sp; v1 = *(const f32x4*)(sp + (size_t)32 * ldw); }
    for (int t = bid; t < ntiles; t += gstep) {
        f32x4 w0 = v0, w1 = v1;
        if (t + gstep < ntiles) { const float* sp = src_of(t + gstep); v0 = *(const f32x4*)sp; v1 = *(const f32x4*)(sp + (size_t)32 * ldw); }
        const int k0 = (t / tn) * 64, n0 = (t % tn) * 32;
#pragma unroll
        for (int j = 0; j < 4; ++j) { T[(n4 + j) * 72 + kk] = f2bf(w0[j]); T[(n4 + j) * 72 + kk + 32] = f2bf(w1[j]); }
        __syncthreads();
        const int n = tid >> 3, kq = (tid & 7) * 8;
        *(u32x4*)(Wt + (size_t)(n0 + n) * ldo + k0 + kq) = *(const u32x4*)&T[n * 72 + kq];
        __syncthreads();
    }
}
DI void gen_t1(bf16_t* T, int N1, int gtid, int gthreads) {
    const int S = 2 * N1;
    for (int i = gtid; i < S * S; i += gthreads) {
        const int m2 = i / S, kk = i % S, k1 = m2 >> 1, ro = m2 & 1, n1 = kk >> 1, ri = kk & 1;
        const int q = (n1 * k1) % N1; float s, c; sincospif(2.f * (float)q / (float)N1, &s, &c);
        const float v = ro == 0 ? (ri == 0 ? c : s) : (ri == 0 ? -s : c);
        T[i] = f2bf(v);
    }
}
DI void gen_t2(bf16_t* T, int N2, int gtid, int gthreads) {
    const int S = 2 * N2;
    for (int i = gtid; i < N2 * S; i += gthreads) {
        const int k2 = i / S, kk = i % S, n2 = kk >> 1, ri = kk & 1;
        const int q = (n2 * k2) % N2; float s, c; sincospif(2.f * (float)q / (float)N2, &s, &c);
        T[i] = f2bf(ri == 0 ? c : s);
    }
}
DI void phase_prep(const Params& p, int l, char* smem) {
    const int tid = TID_, lane = tid & 63, wave = tid >> 6;
    const int gtid = BID_ * 256 + tid, gthreads = GDIM_ * 256;
    char* ws = p.ws;
    if (l == 0) {
        float* sil = (float*)smem;
        float* red = sil + 3072;
        for (int item = BID_; item < 192; item += GDIM_) {
            const int ll = item / 96, cgp = item % 96;
            for (int i = tid; i < 3072; i += 256) {
                const int s = i >> 10, k = i & 1023;
                const float x = s < 2 ? p.in[1][s * 1024 + k] : p.in[3][k];
                sil[i] = x / (1.f + __expf(-x));
            }
            __syncthreads();
            const int col = cgp * 64 + lane;
            const float* wp = p.in[4] + (size_t)ll * 1024 * 6144 + col;
            float a0 = 0.f, a1 = 0.f, a2 = 0.f;
#pragma unroll 32
            for (int k = wave * 256; k < wave * 256 + 256; ++k) {
                const float w = wp[(size_t)k * 6144];
                a0 += sil[k] * w; a1 += sil[1024 + k] * w; a2 += sil[2048 + k] * w;
            }
            red[(wave * 3 + 0) * 64 + lane] = a0; red[(wave * 3 + 1) * 64 + lane] = a1; red[(wave * 3 + 2) * 64 + lane] = a2;
            __syncthreads();
            if (wave < 3) {
                const float v = red[(0 * 3 + wave) * 64 + lane] + red[(1 * 3 + wave) * 64 + lane] + red[(2 * 3 + wave) * 64 + lane] + red[(3 * 3 + wave) * 64 + lane];
                ((float*)(ws + OFF_MOD))[(size_t)(ll * 3 + wave) * 6144 + col] = v + p.in[5][ll * 6144 + col];
            }
            __syncthreads();
        }
        float* rc = (float*)(ws + OFF_ROPE); float* rs = rc + 8192 * 16;
        for (int i = gtid; i < 8192 * 16; i += gthreads) {
            const int t = i >> 4, ii = i & 15, m = ii & 7;
            const float inv = powf(10000.f, -(float)(2 * m) / 16.f);
            const float pos = (float)(ii < 8 ? (t >> 6) : (t & 63));
            const float ang = pos * inv;
            rc[i] = cosf(ang); rs[i] = sinf(ang);
        }
        float* tw = (float*)(ws + OFF_TW8192);
        for (int i = gtid; i < 8192; i += gthreads) { float s, c; sincospif(2.f * (float)i / 8192.f, &s, &c); tw[2 * i] = c; tw[2 * i + 1] = s; }
        float* tw2 = (float*)(ws + OFF_TW256);
        for (int i = gtid; i < 256; i += gthreads) { float s, c; sincospif(2.f * (float)i / 256.f, &s, &c); tw2[2 * i] = c; tw2[2 * i + 1] = s; }
        bf16_t* t0 = (bf16_t*)(ws + OFF_T0);
        for (int i = gtid; i < 128 * 64; i += gthreads) {
            const int c2 = i >> 6, j = i & 63, kp = c2 >> 1, ri = c2 & 1;
            float s, c; sincospif(2.f * (float)((j * kp) & 63) / 64.f, &s, &c);
            t0[i] = f2bf(ri == 0 ? c : -s);
        }
        gen_t1((bf16_t*)(ws + OFF_T1L), 128, gtid, gthreads);
        gen_t1((bf16_t*)(ws + OFF_T1C), 16, gtid, gthreads);
        gen_t2((bf16_t*)(ws + OFF_T2L), 64, gtid, gthreads);
        gen_t2((bf16_t*)(ws + OFF_T2C), 16, gtid, gthreads);
    }
    {
        float* abar = (float*)(ws + OFF_ABAR); float* a64 = (float*)(ws + OFF_A64); bf16_t* bbt = (bf16_t*)(ws + OFF_BBAR);
        for (int i = gtid; i < 2 * 24 * 64; i += gthreads) {
            const int n = i & 63, dg = i >> 6;
            const size_t pi = (size_t)l * 2 * 24 * 64 + i;
            const float are = p.in[13][pi], aim = p.in[14][pi];
            const float dt = expf(p.in[15][l * 48 + dg]);
            const float mag = expf(dt * are); float sn, cs; sincosf(dt * aim, &sn, &cs);
            const float br = mag * cs, bi = mag * sn;
            abar[2 * i] = br; abar[2 * i + 1] = bi;
            float pr = br, pim = bi;
#pragma unroll
            for (int k = 0; k < 6; ++k) { const float nr = pr * pr - pim * pim, ni = 2.f * pr * pim; pr = nr; pim = ni; }
            a64[2 * i] = pr; a64[2 * i + 1] = pim;
            const float nr = br - 1.f, ni = bi, den = are * are + aim * aim;
            const float cr = (nr * are + ni * aim) / den, ci = (ni * are - nr * aim) / den;
            const float* bre = p.in[16] + pi * 16; const float* bim = p.in[17] + pi * 16;
#pragma unroll
            for (int q = 0; q < 16; ++q) {
                const float xr = bre[q], xi = bim[q];
                bbt[((size_t)dg * 128 + 2 * n) * 16 + q] = f2bf(cr * xr - ci * xi);
                bbt[((size_t)dg * 128 + 2 * n + 1) * 16 + q] = f2bf(cr * xi + ci * xr);
            }
        }
        bf16_t* cxt = (bf16_t*)(ws + OFF_CXT);
        for (int i = gtid; i < 2 * 24 * 16 * 64; i += gthreads) {
            const size_t pi = (size_t)l * 2 * 24 * 16 * 64 + i;
            const int n = i & 63, dgp = i >> 6;
            cxt[(size_t)dgp * 128 + 2 * n] = f2bf(p.in[18][pi]);
            cxt[(size_t)dgp * 128 + 2 * n + 1] = f2bf(-p.in[19][pi]);
        }
    }
    bf16_t* W = (bf16_t*)(ws + OFF_W);
    conv_job(p.in[8] + (size_t)l * 1024 * 1440, 1024, 1440, 1440, 0, W + WO_IN, LD1, smem);
    conv_job(p.in[26] + (size_t)l * 1024 * 3072, 1024, 3072, 3072, 0, W + WO_GATE, LD1, smem);
    conv_job(p.in[10] + (size_t)l * 384 * 768, 384, 768, 768, 0, W + WO_UQ, 384, smem);
    conv_job(p.in[12] + (size_t)l * 256 * 1024, 256, 512, 1024, 1, W + WO_K, 256, smem);
    conv_job(p.in[12] + (size_t)l * 256 * 1024, 256, 512, 1024, 2, W + WO_V, 256, smem);
    conv_job(p.in[21] + (size_t)l * 384 * 384, 384, 384, 384, 0, W + WO_GLU, 384, smem);
    conv_job(p.in[23] + (size_t)l * 512 * 1024, 512, 1024, 1024, 0, W + WO_BA, 512, smem);
    conv_job(p.in[24] + (size_t)l * 384 * 1024, 384, 1024, 1024, 0, W + WO_BF, 384, smem);
    conv_job(p.in[25] + (size_t)l * 384 * 1024, 384, 1024, 1024, 0, W + WO_BS, 384, smem);
    conv_job(p.in[28] + (size_t)l * 1024 * 1024, 1024, 1024, 1024, 0, W + WO_OUT, LD1, smem);
    conv_job(p.in[29] + (size_t)l * 1024 * 4096, 1024, 4096, 4096, 0, W + WO_1, LD1, smem);
    conv_job(p.in[30] + (size_t)l * 4096 * 1024, 4096, 1024, 1024, 0, W + WO_2, LD4, smem);
}

DI void phase_norm(const Params& p, int l, int which) {
    const int lane = TID_ & 63, gw = BID_ * 4 + (TID_ >> 6), nw = GDIM_ * 4;
    const float* ln = p.in[which == 0 ? 6 : 7] + l * 1024;
    const bool orig = (which == 0 && l == 0);
    bf16_t* H = (bf16_t*)(p.ws + OFF_H);
    for (int row = gw; row < R; row += nw) {
        const float* x = xptr(p, orig, row);
        const float* mod = (const float*)(p.ws + OFF_MOD) + (size_t)(l * 3 + srow_of(row)) * 6144 + (which == 0 ? 0 : 3072);
        f32x4 v[4]; float ss = 0.f;
#pragma unroll
        for (int i = 0; i < 4; ++i) { v[i] = *(const f32x4*)(x + i * 256 + lane * 4); ss += v[i][0] * v[i][0] + v[i][1] * v[i][1] + v[i][2] * v[i][2] + v[i][3] * v[i][3]; }
        if (orig && (row % TPB) < CTX) {
            float* xc = xptr(p, false, row);
#pragma unroll
            for (int i = 0; i < 4; ++i) *(f32x4*)(xc + i * 256 + lane * 4) = v[i];
        }
        ss = wave_sum(ss);
        const float rstd = rsqrtf(ss * (1.f / 1024.f) + 1e-6f);
#pragma unroll
        for (int i = 0; i < 4; ++i) {
            const int c = i * 256 + lane * 4;
            const f32x4 g = *(const f32x4*)(ln + c), sh = *(const f32x4*)(mod + c), sc = *(const f32x4*)(mod + 1024 + c);
            float o[4];
#pragma unroll
            for (int j = 0; j < 4; ++j) o[j] = v[i][j] * rstd * g[j] * (1.f + sc[j]) + sh[j];
            st_bf4(H + (size_t)row * LD1 + c, o[0], o[1], o[2], o[3]);
        }
    }
}
DI void phase_final(const Params& p) {
    const int lane = TID_ & 63, gw = BID_ * 4 + (TID_ >> 6), nw = GDIM_ * 4;
    const float* fn = p.in[31];
    for (int r = gw; r < 2 * SEQ; r += nw) {
        float* x = p.out + (size_t)r * 1024;
        f32x4 v[4]; float ss = 0.f;
#pragma unroll
        for (int i = 0; i < 4; ++i) { v[i] = *(const f32x4*)(x + i * 256 + lane * 4); ss += v[i][0] * v[i][0] + v[i][1] * v[i][1] + v[i][2] * v[i][2] + v[i][3] * v[i][3]; }
        ss = wave_sum(ss);
        const float rstd = rsqrtf(ss * (1.f / 1024.f) + 1e-6f);
#pragma unroll
        for (int i = 0; i < 4; ++i) {
            const int c = i * 256 + lane * 4;
            const f32x4 g = *(const f32x4*)(fn + c);
            f32x4 o;
#pragma unroll
            for (int j = 0; j < 4; ++j) o[j] = v[i][j] * rstd * g[j];
            *(f32x4*)(x + c) = o;
        }
    }
}
DI void unpack8(u32x4 w, float (&v)[8]) { v[0] = bflo(w.x); v[1] = bfhi(w.x); v[2] = bflo(w.y); v[3] = bfhi(w.y); v[4] = bflo(w.z); v[5] = bfhi(w.z); v[6] = bflo(w.w); v[7] = bfhi(w.w); }
DI u32x4 pack8(const float (&v)[8]) { u32x4 w; w.x = pack2(v[0], v[1]); w.y = pack2(v[2], v[3]); w.z = pack2(v[4], v[5]); w.w = pack2(v[6], v[7]); return w; }
DI void phase_znorm(const Params& p, int l) {
    const int lane = TID_ & 63, gw = BID_ * 4 + (TID_ >> 6), nw = GDIM_ * 4;
    const bf16_t* Z = (const bf16_t*)(p.ws + OFF_Z);
    bf16_t* QIN = (bf16_t*)(p.ws + OFF_T + T_QIN); bf16_t* CKV = (bf16_t*)(p.ws + OFF_T + T_CKV); bf16_t* Kb = (bf16_t*)(p.ws + OFF_K);
    const float* qn = p.in[9] + l * 384; const float* kvn = p.in[11] + l * 256;
    const float* rc = (const float*)(p.ws + OFF_ROPE); const float* rs = rc + 8192 * 16;
    for (int row = gw; row < R; row += nw) {
        const bf16_t* z = Z + (size_t)row * 1440;
        float q[8], k[8], ssq = 0.f, ssk = 0.f;
        if (lane < 48) { unpack8(*(const u32x4*)(z + lane * 8), q);
#pragma unroll
            for (int j = 0; j < 8; ++j) ssq += q[j] * q[j]; }
        if (lane < 32) { unpack8(*(const u32x4*)(z + 384 + lane * 8), k);
#pragma unroll
            for (int j = 0; j < 8; ++j) ssk += k[j] * k[j]; }
        ssq = wave_sum(ssq); ssk = wave_sum(ssk);
        const float rq = rsqrtf(ssq * (1.f / 384.f) + 1e-6f), rk = rsqrtf(ssk * (1.f / 256.f) + 1e-6f);
        if (lane < 48) {
            const f32x4 g0 = *(const f32x4*)(qn + lane * 8), g1 = *(const f32x4*)(qn + lane * 8 + 4);
#pragma unroll
            for (int j = 0; j < 4; ++j) { q[j] *= rq * g0[j]; q[4 + j] *= rq * g1[j]; }
            *(u32x4*)(QIN + (size_t)row * 384 + lane * 8) = pack8(q);
        }
        if (lane < 32) {
            const f32x4 g0 = *(const f32x4*)(kvn + lane * 8), g1 = *(const f32x4*)(kvn + lane * 8 + 4);
#pragma unroll
            for (int j = 0; j < 4; ++j) { k[j] *= rk * g0[j]; k[4 + j] *= rk * g1[j]; }
            *(u32x4*)(CKV + (size_t)row * 256 + lane * 8) = pack8(k);
            const int h = lane >> 2, part = lane & 3, i0 = (part & 1) * 8, t = row % TPB;
            float x1[8], x2[8], o[8];
            unpack8(*(const u32x4*)(z + 640 + i0), x1); unpack8(*(const u32x4*)(z + 656 + i0), x2);
            if (t >= CTX) {
                const float* cp = rc + (size_t)(t - CTX) * 16 + i0; const float* sp = rs + (size_t)(t - CTX) * 16 + i0;
                const f32x4 c0 = *(const f32x4*)cp, c1 = *(const f32x4*)(cp + 4), s0 = *(const f32x4*)sp, s1 = *(const f32x4*)(sp + 4);
#pragma unroll
                for (int j = 0; j < 8; ++j) { const float c = j < 4 ? c0[j & 3] : c1[j & 3], s = j < 4 ? s0[j & 3] : s1[j & 3];
                    o[j] = part < 2 ? x1[j] * c - x2[j] * s : x2[j] * c + x1[j] * s; }
            } else {
#pragma unroll
                for (int j = 0; j < 8; ++j) o[j] = part < 2 ? x1[j] : x2[j];
            }
            *(u32x4*)(Kb + (size_t)row * 768 + h * 96 + 64 + part * 8) = pack8(o);
        }
    }
}

#define FOR_TILES(MT, NT, SN) \
    const int xcd_ = BID_ & 7, slot_ = BID_ >> 3, spx_ = GDIM_ >> 3, SM_ = 64 / (SN), nsn_ = (NT) / (SN), nst_ = (((MT) + SM_ - 1) / SM_) * nsn_; \
    for (int s_ = xcd_; s_ < nst_; s_ += 8) for (int sl_ = slot_; sl_ < 64; sl_ += spx_)
#define TILE_MT(SN) ((s_ / nsn_) * SM_ + sl_ / (SN))
#define TILE_NT(SN) ((s_ % nsn_) * (SN) + sl_ % (SN))
DI void phase_gemm_z(const Params& p, char* smem8) {
    const bf16_t* H = (const bf16_t*)(p.ws + OFF_H); const bf16_t* W = (const bf16_t*)(p.ws + OFF_W) + WO_IN; bf16_t* Z = (bf16_t*)(p.ws + OFF_Z);
    for (int tile = PBID_; tile < 66 * 6; tile += PGDIM_) {
        const int row0 = (tile / 6) * 256, col0 = (tile % 6) * 256;
        f32x4 acc[8][4];
        gemm_main3(acc, H, LD1, R, W, LD1, 1440, 1024, row0, col0, smem8);
        stage_tile8(acc, smem8, Z, 1440, row0, col0, 1440);
    }
}
DI void phase_gemm_qkv(const Params& p, char* smem) {
    const bf16_t* QIN = (const bf16_t*)(p.ws + OFF_T + T_QIN); const bf16_t* CKV = (const bf16_t*)(p.ws + OFF_T + T_CKV);
    const bf16_t* W = (const bf16_t*)(p.ws + OFF_W);
    bf16_t* Qb = (bf16_t*)(p.ws + OFF_Q); bf16_t* Kb = (bf16_t*)(p.ws + OFF_K); bf16_t* Vt = (bf16_t*)(p.ws + OFF_VT);
    const float* rc = (const float*)(p.ws + OFF_ROPE); const float* rs = rc + 8192 * 16;
    const float qscale = 0.10206207261596577f * 1.4426950408889634f;
    for (int tile = BID_; tile < 792 + 528 + 528; tile += GDIM_) {
        f32x4 acc[4][4];
        if (tile < 792) {
            const int row0 = (tile / 6) * 128, col0 = (tile % 6) * 128;
            gemm_main(acc, QIN, 384, R, W + WO_UQ, 384, 768, 384, row0, col0, smem);
            EPI_VARS
            const int gn0 = (col0 + wn_ * 64) >> 4;
#pragma unroll
            for (int mi = 0; mi < 4; ++mi) {
                const int row = EPI_ROW(mi), t = row % TPB;
#pragma unroll
                for (int ni = 0; ni < 3; ++ni) {
                    if ((gn0 + ni) % 6 == 4 && t >= CTX) {
                        const f32x4 c = *(const f32x4*)(rc + (size_t)(t - CTX) * 16 + quad_ * 4), s = *(const f32x4*)(rs + (size_t)(t - CTX) * 16 + quad_ * 4);
                        const f32x4 x1 = acc[mi][ni], x2 = acc[mi][ni + 1];
                        acc[mi][ni] = x1 * c - x2 * s; acc[mi][ni + 1] = x2 * c + x1 * s;
                    }
                }
#pragma unroll
                for (int ni = 0; ni < 4; ++ni) acc[mi][ni] *= qscale;
            }
            stage_tile_bf16<4>(acc, smem, Qb, 768, row0, col0, 768);
        } else if (tile < 792 + 528) {
            const int tt = tile - 792, row0 = (tt / 4) * 128, col0 = (tt % 4) * 128;
            gemm_main(acc, CKV, 256, R, W + WO_K, 256, 512, 256, row0, col0, smem);
            EPI_VARS
            stage_tile_bf16<4>(acc, smem, Kb, 768, row0, col0, 512, true);
        } else {
            const int tt = tile - 792 - 528, row0 = (tt & 3) * 128, col0 = (tt >> 2) * 128;
            gemm_main(acc, W + WO_V, 256, 512, CKV, 256, R, 256, row0, col0, smem);
            EPI_VARS
            { const int b_ = col0 / TPB, t0_ = col0 - b_ * TPB;
              stage_tile_bf16<4>(acc, smem, Vt + (size_t)(b_ * 512) * TPB + t0_, TPB, row0, 0, 128); }
        }
    }
}
DI void phase_gemm_glu(const Params& p, int l, char* smem) {
    const bf16_t* YG = (const bf16_t*)(p.ws + OFF_T + T_YG); const bf16_t* W = (const bf16_t*)(p.ws + OFF_W) + WO_GLU; bf16_t* OS = (bf16_t*)(p.ws + OFF_OS);
    const float* bg = p.in[22] + l * 384;
    for (int tile = BID_; tile < 132 * 3; tile += GDIM_) {
        const int row0 = (tile / 3) * 128, col0 = (tile % 3) * 128;
        f32x4 acc[4][4];
        gemm_main(acc, YG, 384, R, W, 384, 384, 384, row0, col0, smem);
        EPI_VARS
#pragma unroll
        for (int mi = 0; mi < 4; ++mi)
#pragma unroll
            for (int ni = 0; ni < 4; ++ni) {
                const int row = EPI_ROW(mi), col = EPI_COL(ni);
                const uint2 yw = *(const uint2*)(YG + (size_t)row * 384 + col);
                const f32x4 b = *(const f32x4*)(bg + col);
                const float y0 = bflo(yw.x), y1 = bfhi(yw.x), y2 = bflo(yw.y), y3 = bfhi(yw.y);
                st_bf4(OS + (size_t)row * 384 + col, y0 * sigmoidf_(acc[mi][ni][0] + b[0]), y1 * sigmoidf_(acc[mi][ni][1] + b[1]),
                       y2 * sigmoidf_(acc[mi][ni][2] + b[2]), y3 * sigmoidf_(acc[mi][ni][3] + b[3]));
            }
    }
}
DI void phase_merge(const Params& p, int l, char* smem, char* smem8) {
    const bf16_t* H = (const bf16_t*)(p.ws + OFF_H); const bf16_t* W = (const bf16_t*)(p.ws + OFF_W);
    const bf16_t* OA = (const bf16_t*)(p.ws + OFF_OA); const bf16_t* OFb = (const bf16_t*)(p.ws + OFF_OF); const bf16_t* OS = (const bf16_t*)(p.ws + OFF_OS);
    bf16_t* M = (bf16_t*)(p.ws + OFF_Z);
    const float* bgate = p.in[27] + l * 3072;
    for (int tile0 = PBID_; tile0 < 256; tile0 += PGDIM_) {
        const int tile = PGDIM_ == 256 ? ((((tile0 & 7) * 8 + (tile0 >> 5)) << 2) | ((tile0 >> 3) & 3)) : tile0;
        const int rt = tile >> 2, row0 = ((rt >> 5) * 33 + 1 + (rt & 31)) * 256, col0 = (tile & 3) * 256;
#pragma unroll 1
        for (int br = 0; br < 3; ++br) {
            f32x4 acc[8][4];
            gemm_main3(acc, H, LD1, R, W + WO_GATE + (size_t)br * 1024 * LD1, LD1, 1024, 1024, row0, col0, smem8);
            {
                EPI8_VARS
                unsigned* gs = (unsigned*)(p.ws + OFF_Q) + ((size_t)tile * 2 * 64 * 512) + tid8_;
                const float* bg = bgate + br * 1024 + col0 + wc_ * 64 + quade_ * 4;
#pragma unroll
                for (int mi = 0; mi < 8; ++mi) {
                    __builtin_amdgcn_sched_barrier(0);
#pragma unroll
                    for (int ni = 0; ni < 4; ++ni) {
                        const f32x4 bb = *(const f32x4*)(bg + ni * 16);
                        gs[((mi * 4 + ni) * 2 + 0) * 512] = pack2(sigmoidf_(acc[mi][ni][0] + bb[0]), sigmoidf_(acc[mi][ni][1] + bb[1]));
                        gs[((mi * 4 + ni) * 2 + 1) * 512] = pack2(sigmoidf_(acc[mi][ni][2] + bb[2]), sigmoidf_(acc[mi][ni][3] + bb[3]));
                    }
                }
            }
            const bf16_t* Ab = br == 0 ? OA : (br == 1 ? OFb : OS);
            const int Kb = br == 0 ? 512 : 384;
            const bf16_t* Wb = W + (br == 0 ? WO_BA : (br == 1 ? WO_BF : WO_BS));
            gemm_main3(acc, Ab, Kb, R, Wb, Kb, 1024, Kb, row0, col0, smem8);
            {
                EPI8_VARS
                unsigned* gs = (unsigned*)(p.ws + OFF_Q) + ((size_t)tile * 2 * 64 * 512) + tid8_;
                unsigned* ts = gs + 64 * 512;
#pragma unroll
                for (int mi = 0; mi < 8; ++mi) {
                    __builtin_amdgcn_sched_barrier(0);
#pragma unroll
                    for (int ni = 0; ni < 4; ++ni) {
                        const unsigned g0 = gs[((mi * 4 + ni) * 2 + 0) * 512], g1 = gs[((mi * 4 + ni) * 2 + 1) * 512];
                        f32x4 t = {0.f, 0.f, 0.f, 0.f};
                        if (br > 0) { const unsigned t0 = ts[((mi * 4 + ni) * 2 + 0) * 512], t1 = ts[((mi * 4 + ni) * 2 + 1) * 512]; t = (f32x4){bflo(t0), bfhi(t0), bflo(t1), bfhi(t1)}; }
                        t[0] += bflo(g0) * acc[mi][ni][0]; t[1] += bfhi(g0) * acc[mi][ni][1]; t[2] += bflo(g1) * acc[mi][ni][2]; t[3] += bfhi(g1) * acc[mi][ni][3];
                        if (br < 2) { ts[((mi * 4 + ni) * 2 + 0) * 512] = pack2(t[0], t[1]); ts[((mi * 4 + ni) * 2 + 1) * 512] = pack2(t[2], t[3]); }
                        acc[mi][ni] = t;
                    }
                }
            }
            if (br == 2) stage_tile8(acc, smem8, M, LD1, row0, col0, 1024);
        }
    }
    const int nctx = (l == 0 ? 32 : 0);
    for (int tile = BID_; tile < nctx; tile += GDIM_) {
        const int ct = tile >> 3, row0 = (ct >> 1) * TPB + (ct & 1) * 128, col0 = (tile & 7) * 128;
        const size_t sbase = (size_t)256 * 2 * 64 * 512 + (size_t)tile * 32 * 256;
#pragma unroll 1
        for (int br = 0; br < 3; ++br) {
            {
                f32x4 acc[4][4];
                gemm_main(acc, H, LD1, R, W + WO_GATE + (size_t)br * 1024 * LD1, LD1, 1024, 1024, row0, col0, smem);
                EPI_VARS
                unsigned* gs = (unsigned*)(p.ws + OFF_Q) + sbase + tid_;
#pragma unroll
                for (int mi = 0; mi < 4; ++mi)
#pragma unroll
                    for (int ni = 0; ni < 4; ++ni) {
                        const f32x4 b = *(const f32x4*)(bgate + br * 1024 + EPI_COL(ni));
                        gs[((mi * 4 + ni) * 2 + 0) * 256] = pack2(sigmoidf_(acc[mi][ni][0] + b[0]), sigmoidf_(acc[mi][ni][1] + b[1]));
                        gs[((mi * 4 + ni) * 2 + 1) * 256] = pack2(sigmoidf_(acc[mi][ni][2] + b[2]), sigmoidf_(acc[mi][ni][3] + b[3]));
                    }
            }
            f32x4 acc[4][4];
            const bf16_t* Ab = br == 0 ? OA : (br == 1 ? OFb : OS);
            const int Kb = br == 0 ? 512 : 384;
            const bf16_t* Wb = W + (br == 0 ? WO_BA : (br == 1 ? WO_BF : WO_BS));
            gemm_main(acc, Ab, Kb, R, Wb, Kb, 1024, Kb, row0, col0, smem);
            EPI_VARS
            const unsigned* gs = (const unsigned*)(p.ws + OFF_Q) + sbase + tid_;
#pragma unroll
            for (int mi = 0; mi < 4; ++mi)
#pragma unroll
                for (int ni = 0; ni < 4; ++ni) {
                    const unsigned g0 = gs[((mi * 4 + ni) * 2 + 0) * 256], g1 = gs[((mi * 4 + ni) * 2 + 1) * 256];
                    uint2* mp = (uint2*)(M + (size_t)EPI_ROW(mi) * LD1 + EPI_COL(ni));
                    uint2 t = make_uint2(0u, 0u);
                    if (br > 0) t = *mp;
                    t.x = pack2(bflo(t.x) + bflo(g0) * acc[mi][ni][0], bfhi(t.x) + bfhi(g0) * acc[mi][ni][1]);
                    t.y = pack2(bflo(t.y) + bflo(g1) * acc[mi][ni][2], bfhi(t.y) + bfhi(g1) * acc[mi][ni][3]);
                    *mp = t;
                }
        }
    }
}
DI void phase_gemm_res(const Params& p, int l, int which, char* smem, char* smem8) {
    const bf16_t* A = (const bf16_t*)(p.ws + OFF_Z); const bf16_t* W = (const bf16_t*)(p.ws + OFF_W) + (which == 0 ? WO_OUT : WO_2);
    const int K = which == 0 ? 1024 : 4096, LDK = which == 0 ? LD1 : LD4;
    const bool orig = (which == 0 && l == 0);
    const int goff = which == 0 ? 2048 : 5120;
    {
        for (int tile0 = PBID_; tile0 < 256; tile0 += PGDIM_) {
            const int tile = PGDIM_ == 256 ? ((((tile0 & 7) * 8 + (tile0 >> 5)) << 2) | ((tile0 >> 3) & 3)) : tile0;
            const int rt = tile >> 2, row0 = ((rt >> 5) * 33 + 1 + (rt & 31)) * 256, col0 = (tile & 3) * 256;
            f32x4 acc[8][4];
            gemm_main3(acc, A, LDK, R, W, LDK, 1024, K, row0, col0, smem8);
            EPI8_VARS
            const int b_ = rt >> 5;
            const size_t lat0 = (size_t)(b_ * SEQ + (rt & 31) * 256) * 1024;
            const float* xin = (orig ? p.in[0] : p.out) + lat0; float* xout = p.out + lat0;
            const float* gate = (const float*)(p.ws + OFF_MOD) + (size_t)(l * 3 + b_) * 6144 + goff;
#pragma unroll
            for (int mi = 0; mi < 8; ++mi) {
                __builtin_amdgcn_sched_barrier(0);
                const size_t ro = (size_t)(wr_ * 128 + mi * 16 + l15e_) * 1024;
#pragma unroll
                for (int ni = 0; ni < 4; ++ni) {
                    const int col = EPI8_COL(ni);
                    const f32x4 x = *(const f32x4*)(xin + ro + col), g = *(const f32x4*)(gate + col);
                    *(f32x4*)(xout + ro + col) = x + g * acc[mi][ni];
                }
            }
        }
    }
    const int ksh = which == 0 ? 2 : 3, KS = 1 << ksh, Kc = K >> ksh;
    const int nitems = (l == 0 ? 32 << ksh : 0);
    for (int item = BID_; item < nitems; item += GDIM_) {
        const int tt = item >> ksh, kp = item & (KS - 1), ct = tt >> 3, row0 = (ct >> 1) * TPB + (ct & 1) * 128, col0 = (tt & 7) * 128;
        f32x4 acc[4][4];
        gemm_main(acc, A + kp * Kc, LDK, R, W + kp * Kc, LDK, 1024, Kc, row0, col0, smem);
        EPI_VARS
        float* xcb = (float*)(p.ws + OFF_XC) + (size_t)((ct >> 1) * CTX + (ct & 1) * 128) * 1024;
        const float* gate = (const float*)(p.ws + OFF_MOD) + (size_t)(l * 3 + 2) * 6144 + goff;
#pragma unroll
        for (int mi = 0; mi < 4; ++mi) {
            __builtin_amdgcn_sched_barrier(0);
            float* xo = xcb + (size_t)(wm_ * 64 + mi * 16 + l15_) * 1024;
#pragma unroll
            for (int ni = 0; ni < 4; ++ni) {
                const int col = EPI_COL(ni);
                const f32x4 g = *(const f32x4*)(gate + col);
#pragma unroll
                for (int j = 0; j < 4; ++j) unsafeAtomicAdd(xo + col + j, g[j] * acc[mi][ni][j]);
            }
        }
    }
}
DI void phase_mlp1(const Params& p, int l, char* smem, char* smem8) {
    const bf16_t* H = (const bf16_t*)(p.ws + OFF_H); const bf16_t* W = (const bf16_t*)(p.ws + OFF_W) + WO_1; bf16_t* U = (bf16_t*)(p.ws + OFF_Z);
    for (int tile = PBID_; tile < 1024; tile += PGDIM_) {
        const int rt = tile >> 4, row0 = ((rt >> 5) * 33 + 1 + (rt & 31)) * 256, col0 = (tile & 15) * 256;
        f32x4 acc[8][4];
        gemm_main3(acc, H, LD1, R, W, LD1, 4096, 1024, row0, col0, smem8);
#pragma unroll
        for (int mi = 0; mi < 8; ++mi)
#pragma unroll
            for (int ni = 0; ni < 4; ++ni)
#pragma unroll
                for (int j = 0; j < 4; ++j) { const float r = fmaxf(acc[mi][ni][j], 0.f); acc[mi][ni][j] = r * r; }
        stage_tile8(acc, smem8, U, LD4, row0, col0, 4096);
    }
    const int ntiles = (l == 0 ? 128 : 0);
    for (int tile = BID_; tile < ntiles; tile += GDIM_) {
        const int ct = tile >> 5, row0 = (ct >> 1) * TPB + (ct & 1) * 128, col0 = (tile & 31) * 128;
        f32x4 acc[4][4];
        gemm_main(acc, H, LD1, R, W, LD1, 4096, 1024, row0, col0, smem);
#pragma unroll
        for (int mi = 0; mi < 4; ++mi)
#pragma unroll
            for (int ni = 0; ni < 4; ++ni)
#pragma unroll
                for (int j = 0; j < 4; ++j) { const float r = fmaxf(acc[mi][ni][j], 0.f); acc[mi][ni][j] = r * r; }
        stage_tile_bf16<4>(acc, smem, U, LD4, row0, col0, 4096);
    }
}

DI void attn_item(const Params& p, int b, int h, int qrow0, int nkeys, char* smem) {
    const int tid = TID_, lane = tid & 63, wave = tid >> 6, l15 = lane & 15, quad = lane >> 4;
    const bf16_t* Qb = (const bf16_t*)(p.ws + OFF_Q); const bf16_t* Kb = (const bf16_t*)(p.ws + OFF_K); const bf16_t* Vt = (const bf16_t*)(p.ws + OFF_VT);
    bf16_t* OA = (bf16_t*)(p.ws + OFF_OA);
    char* Ks = smem;
    bf16_t* Vs = (bf16_t*)(smem + 2 * 12288);
    bf16x8 qf[4][3];
#pragma unroll
    for (int qt = 0; qt < 4; ++qt)
#pragma unroll
        for (int s = 0; s < 3; ++s) qf[qt][s] = *(const bf16x8*)(Qb + (size_t)(qrow0 + wave * 64 + qt * 16 + l15) * 768 + h * 96 + s * 32 + quad * 8);
    f32x4 o[4][4];
#pragma unroll
    for (int i = 0; i < 4; ++i)
#pragma unroll
        for (int j = 0; j < 4; ++j) o[i][j] = (f32x4){0.f, 0.f, 0.f, 0.f};
    float m[4] = {0.f, 0.f, 0.f, 0.f}, lsum[4] = {0.f, 0.f, 0.f, 0.f};
    bool first = true;
    int kp[3], vp[2];
    const bf16_t* kbase = Kb + ((size_t)b * TPB) * 768 + h * 96; const bf16_t* vbase = Vt + (size_t)(b * 8 + h) * 64 * TPB;
    const int sb_ = lane * 16, swz_ = sb_ ^ (((sb_ >> 9) & 1) << 5), sr_ = swz_ >> 6, sk_ = (swz_ & 63) >> 1;
    const int lo = (l15 * 64 + quad * 16) ^ ((l15 >> 3) << 5);
#pragma unroll
    for (int i = 0; i < 3; ++i) { const int st = wave + 4 * i, key = (st / 3) * 16 + sr_, dim = (st % 3) * 32 + sk_; kp[i] = key * 768 + dim; }
#pragma unroll
    for (int i = 0; i < 2; ++i) { const int d = (wave * 2 + i) * 8 + (lane >> 3), c = (lane & 7) ^ ((d >> 1) & 7); vp[i] = d * TPB + c * 8; }
    const int kofs = wave * 1024 + lane * 16;
    const int vofs = wave * 2048 + lane * 16;
    u32x4 kr[3], vr[2];
#pragma unroll
    for (int i = 0; i < 3; ++i) kr[i] = *(const u32x4*)(kbase + kp[i]);
#pragma unroll
    for (int i = 0; i < 2; ++i) vr[i] = *(const u32x4*)(vbase + vp[i]);
#pragma unroll
    for (int i = 0; i < 3; ++i) *(u32x4*)(Ks + i * 4096 + kofs) = kr[i];
#pragma unroll
    for (int i = 0; i < 2; ++i) *(u32x4*)((char*)Vs + i * 1024 + vofs) = vr[i];
    __syncthreads();
    const int NT = nkeys >> 6;
    for (int it = 0; it < NT; ++it) {
        const int buf = it & 1;
        if (it + 1 < NT) {
#pragma unroll
            for (int i = 0; i < 3; ++i) kr[i] = *(const u32x4*)(kbase + (size_t)(it + 1) * 64 * 768 + kp[i]);
#pragma unroll
            for (int i = 0; i < 2; ++i) vr[i] = *(const u32x4*)(vbase + (it + 1) * 64 + vp[i]);
        }
#pragma unroll
        for (int hk = 0; hk < 2; ++hk) {
            f32x4 s[2][4];
#pragma unroll
            for (int k2 = 0; k2 < 2; ++k2) {
#pragma unroll
                for (int qt = 0; qt < 4; ++qt) { const float nm = -m[qt]; s[k2][qt] = (f32x4){nm, nm, nm, nm}; }
#pragma unroll
                for (int ss = 0; ss < 3; ++ss) {
                    const bf16x8 kf = *(const bf16x8*)(Ks + buf * 12288 + ((hk * 2 + k2) * 3 + ss) * 1024 + lo);
#pragma unroll
                    for (int qt = 0; qt < 4; ++qt) s[k2][qt] = MFMA16(kf, qf[qt][ss], s[k2][qt]);
                }
            }
            bf16x8 pf[4];
#pragma unroll
            for (int qt = 0; qt < 4; ++qt) {
                float mx = max3f(s[0][qt][0], s[0][qt][1], s[0][qt][2]);
                mx = max3f(mx, s[0][qt][3], s[1][qt][0]);
                mx = max3f(mx, s[1][qt][1], s[1][qt][2]);
                mx = fmaxf(mx, s[1][qt][3]);
                if (__builtin_amdgcn_ballot_w64(mx > 8.f || first) != 0) {
                    mx = fmaxf(mx, shx(mx, 16)); mx = fmaxf(mx, shx(mx, 32));
                    const float d = first ? mx : fmaxf(mx, 0.f);
                    const float alpha = __builtin_amdgcn_exp2f(-d);
                    m[qt] += d; lsum[qt] *= alpha;
#pragma unroll
                    for (int dt = 0; dt < 4; ++dt) o[dt][qt] *= alpha;
#pragma unroll
                    for (int k2 = 0; k2 < 2; ++k2)
#pragma unroll
                        for (int j = 0; j < 4; ++j) s[k2][qt][j] -= d;
                }
                float rsum = 0.f;
#pragma unroll
                for (int k2 = 0; k2 < 2; ++k2)
#pragma unroll
                    for (int j = 0; j < 4; ++j) { const float pv = __builtin_amdgcn_exp2f(s[k2][qt][j]); s[k2][qt][j] = pv; rsum += pv; }
                lsum[qt] += rsum;
                u32x4 w;
                w.x = pack2(s[0][qt][0], s[0][qt][1]); w.y = pack2(s[0][qt][2], s[0][qt][3]);
                w.z = pack2(s[1][qt][0], s[1][qt][1]); w.w = pack2(s[1][qt][2], s[1][qt][3]);
                pf[qt] = __builtin_bit_cast(bf16x8, w);
            }
            first = false;
#pragma unroll
            for (int dt = 0; dt < 4; ++dt) {
                const int d_ = dt * 16 + l15, sw_ = (d_ >> 1) & 7, c0_ = hk * 4 + (quad >> 1);
                const char* vb_ = (const char*)Vs + buf * 8192 + d_ * 128 + (quad & 1) * 8;
                const uint2 lo2 = *(const uint2*)(vb_ + ((c0_ ^ sw_) << 4)), hi2 = *(const uint2*)(vb_ + (((c0_ + 2) ^ sw_) << 4));
                u32x4 w; w.x = lo2.x; w.y = lo2.y; w.z = hi2.x; w.w = hi2.y;
                const bf16x8 vf = __builtin_bit_cast(bf16x8, w);
#pragma unroll
                for (int qt = 0; qt < 4; ++qt) o[dt][qt] = MFMA16(vf, pf[qt], o[dt][qt]);
            }
        }
        if (it + 1 < NT) {
#pragma unroll
            for (int i = 0; i < 3; ++i) *(u32x4*)(Ks + (buf ^ 1) * 12288 + i * 4096 + kofs) = kr[i];
#pragma unroll
            for (int i = 0; i < 2; ++i) *(u32x4*)((char*)Vs + (buf ^ 1) * 8192 + i * 1024 + vofs) = vr[i];
        }
        __syncthreads();
    }
#pragma unroll
    for (int qt = 0; qt < 4; ++qt) {
        float ls = lsum[qt]; ls += shx(ls, 16); ls += shx(ls, 32);
        const float inv = 1.f / ls;
        const int row = qrow0 + wave * 64 + qt * 16 + l15;
#pragma unroll
        for (int dt = 0; dt < 4; ++dt)
            st_bf4(OA + (size_t)row * 512 + h * 64 + dt * 16 + quad * 4, o[dt][qt][0] * inv, o[dt][qt][1] * inv, o[dt][qt][2] * inv, o[dt][qt][3] * inv);
    }
}
DI void phase_attn(const Params& p, int l, char* smem) {
    if (PGDIM_ == 256) {
        const int pb = PBID_, x = pb & 7, local = (pb >> 3) * 2 + HALF_;
        const int pr = x + 8 * (local >> 5), qb = local & 31, b = pr >> 3, h = pr & 7;
        attn_item(p, b, h, b * TPB + CTX + qb * 256, TPB, smem);
    } else {
        for (int item = BID_; item < 512; item += GDIM_) { const int qb = item & 31, h = (item >> 5) & 7, b = item >> 8; attn_item(p, b, h, b * TPB + CTX + qb * 256, TPB, smem); }
    }
    if (l == 0)
        for (int it = BID_; it < 16; it += GDIM_) { const int h = it & 7, b = it >> 3; attn_item(p, b, h, b * TPB, CTX, smem); }
}

template <int N1, int N2>
DI void four1_item(const Params& p, int b, int n2, int g, int tok0, const bf16_t* __restrict__ T1, const float* __restrict__ TW, bf16_t* __restrict__ F1, char* smem) {
    const int tid = TID_, lane = tid & 63, wave = tid >> 6, l15 = lane & 15, quad = lane >> 4;
    constexpr int XS = 2 * N1 + 8;
    const bf16_t* Z = (const bf16_t*)(p.ws + OFF_Z); const bf16_t* T0 = (const bf16_t*)(p.ws + OFF_T0);
    bf16_t* Ua = (bf16_t*)smem;
    bf16_t* Xt = Ua + N1 * 72;
    for (int c = tid; c < N1 * 8; c += 256) {
        const int n1 = c >> 3, part = c & 7;
        *(uint4*)&Ua[n1 * 72 + part * 8] = *(const uint4*)(Z + (size_t)(tok0 + N2 * n1 + n2) * 1440 + 672 + g * 64 + part * 8);
    }
    __syncthreads();
    for (int mt = wave; mt < 8; mt += 4) {
        const bf16x8 a0 = *(const bf16x8*)(T0 + (mt * 16 + l15) * 64 + quad * 8);
        const bf16x8 a1 = *(const bf16x8*)(T0 + (mt * 16 + l15) * 64 + 32 + quad * 8);
#pragma unroll
        for (int nt = 0; nt < N1 / 16; ++nt) {
            f32x4 acc = {0.f, 0.f, 0.f, 0.f};
            acc = MFMA16(a0, *(const bf16x8*)&Ua[(nt * 16 + l15) * 72 + quad * 8], acc);
            acc = MFMA16(a1, *(const bf16x8*)&Ua[(nt * 16 + l15) * 72 + 32 + quad * 8], acc);
            const int kp0 = mt * 8 + quad * 2, n1 = nt * 16 + l15;
            *(unsigned*)&Xt[kp0 * XS + 2 * n1] = pack2(acc[0], acc[1]);
            *(unsigned*)&Xt[(kp0 + 1) * XS + 2 * n1] = pack2(acc[2], acc[3]);
        }
    }
    __syncthreads();
    for (int mt = wave; mt < 2 * N1 / 16; mt += 4) {
        constexpr int KS1 = 2 * N1 / 32;
        bf16x8 af[KS1];
#pragma unroll
        for (int ks = 0; ks < KS1; ++ks) af[ks] = *(const bf16x8*)(T1 + (mt * 16 + l15) * (2 * N1) + ks * 32 + quad * 8);
#pragma unroll
        for (int nt = 0; nt < 4; ++nt) {
            f32x4 acc = {0.f, 0.f, 0.f, 0.f};
#pragma unroll
            for (int ks = 0; ks < KS1; ++ks) {
                const bf16x8 bb = *(const bf16x8*)&Xt[(nt * 16 + l15) * XS + ks * 32 + quad * 8];
                acc = MFMA16(af[ks], bb, acc);
            }
            const int k1a = mt * 8 + quad * 2, kp = nt * 16 + l15;
#pragma unroll
            for (int hf = 0; hf < 2; ++hf) {
                const int k1 = k1a + hf; const float orr = acc[2 * hf], oi = acc[2 * hf + 1];
                const float c = TW[2 * (n2 * k1)], s = TW[2 * (n2 * k1) + 1];
                *(unsigned*)&F1[(((size_t)b * N1 + k1) * N2 + n2) * 768 + (g * 64 + kp) * 2] = pack2(orr * c + oi * s, oi * c - orr * s);
            }
        }
    }
    __syncthreads();
}
template <int N1, int N2>
DI void four2_item(const Params& p, int b, int k1, int g, int tok0, const bf16_t* __restrict__ T2, const bf16_t* __restrict__ F1, char* smem) {
    const int tid = TID_, lane = tid & 63, wave = tid >> 6, l15 = lane & 15, quad = lane >> 4;
    constexpr int DS = 2 * N2 + 8;
    bf16_t* OFb = (bf16_t*)(p.ws + OFF_OF);
    bf16_t* Dt = (bf16_t*)smem;
    for (int c = tid; c < N2 * 16; c += 256) {
        const int n2 = c >> 4, part = c & 15;
        const uint4 v = *(const uint4*)(F1 + (((size_t)b * N1 + k1) * N2 + n2) * 768 + g * 128 + part * 8);
        *(unsigned*)&Dt[(part * 4 + 0) * DS + 2 * n2] = v.x; *(unsigned*)&Dt[(part * 4 + 1) * DS + 2 * n2] = v.y;
        *(unsigned*)&Dt[(part * 4 + 2) * DS + 2 * n2] = v.z; *(unsigned*)&Dt[(part * 4 + 3) * DS + 2 * n2] = v.w;
    }
    __syncthreads();
    constexpr float scale = (N1 * N2 == 8192) ? 0.0013810679320049757f : 0.0078125f;
    {
        constexpr int NTT = N2 / 16, KS2 = 2 * N2 / 32;
        const int nt = NTT == 4 ? wave : 0;
        bf16x8 bt[KS2];
#pragma unroll
        for (int ks = 0; ks < KS2; ++ks) bt[ks] = *(const bf16x8*)(T2 + (nt * 16 + l15) * (2 * N2) + ks * 32 + quad * 8);
#pragma unroll
        for (int mi = 0; mi < (NTT == 4 ? 4 : 1); ++mi) {
            const int mt = NTT == 4 ? mi : wave;
            f32x4 acc = {0.f, 0.f, 0.f, 0.f};
#pragma unroll
            for (int ks = 0; ks < KS2; ++ks) {
                const bf16x8 a = *(const bf16x8*)&Dt[(mt * 16 + l15) * DS + ks * 32 + quad * 8];
                acc = MFMA16(a, bt[ks], acc);
            }
            const int k2 = nt * 16 + l15, row = tok0 + k1 + N1 * k2;
            st_bf4(OFb + (size_t)row * 384 + g * 64 + mt * 16 + quad * 4, acc[0] * scale, acc[1] * scale, acc[2] * scale, acc[3] * scale);
        }
    }
    __syncthreads();
}
DI void phase_four1(const Params& p, int l, char* smem) {
    const int nitems = 768 + (l == 0 ? 192 : 0);
    bf16_t* F1L = (bf16_t*)(p.ws + OFF_T + T_F1L); bf16_t* F1C = (bf16_t*)(p.ws + OFF_T + T_F1C);
    for (int item = BID_; item < nitems; item += GDIM_) {
        if (item < 768) { const int g = item % 6, n2 = (item / 6) & 63, b = item / 384;
            four1_item<128, 64>(p, b, n2, g, b * TPB + CTX, (const bf16_t*)(p.ws + OFF_T1L), (const float*)(p.ws + OFF_TW8192), F1L, smem); }
        else { const int it = item - 768, g = it % 6, n2 = (it / 6) & 15, b = it / 96;
            four1_item<16, 16>(p, b, n2, g, b * TPB, (const bf16_t*)(p.ws + OFF_T1C), (const float*)(p.ws + OFF_TW256), F1C, smem); }
    }
}
DI void phase_four2(const Params& p, int l, char* smem) {
    const int nitems = 1536 + (l == 0 ? 192 : 0);
    const bf16_t* F1L = (const bf16_t*)(p.ws + OFF_T + T_F1L); const bf16_t* F1C = (const bf16_t*)(p.ws + OFF_T + T_F1C);
    for (int item = BID_; item < nitems; item += GDIM_) {
        if (item < 1536) { const int g = item % 6, k1 = (item / 6) & 127, b = item / 768;
            four2_item<128, 64>(p, b, k1, g, b * TPB + CTX, (const bf16_t*)(p.ws + OFF_T2L), F1L, smem); }
        else { const int it = item - 1536, g = it % 6, k1 = (it / 6) & 15, b = it / 96;
            four2_item<16, 16>(p, b, k1, g, b * TPB, (const bf16_t*)(p.ws + OFF_T2C), F1C, smem); }
    }
}

#define WAVE_SYNC { __builtin_amdgcn_fence(__ATOMIC_RELEASE, "wavefront"); __builtin_amdgcn_wave_barrier(); __builtin_amdgcn_fence(__ATOMIC_ACQUIRE, "wavefront"); }
DI int ssm_tok(int dir, int sidx) { return dir == 0 ? sidx : (sidx < CTX ? CTX - 1 - sidx : (TPB + CTX - 1) - sidx); }
DI void ssm_load_bbf(const Params& p, int dg, int lane, bf16x8 (&bbf)[8]) {
    const bf16_t* bbt = (const bf16_t*)(p.ws + OFF_BBAR) + (size_t)dg * 128 * 16;
    const int l15 = lane & 15, quad = lane >> 4;
#pragma unroll
    for (int mt = 0; mt < 8; ++mt) {
        bf16x8 v = {0, 0, 0, 0, 0, 0, 0, 0};
        if (quad < 2) v = *(const bf16x8*)(bbt + (mt * 16 + l15) * 16 + quad * 8);
        bbf[mt] = v;
    }
}
template <bool REV, bool STORE>
DI void ssm_sub(const bf16_t* __restrict__ Z, int row0, int g, const bf16x8 (&bbf)[8], float ar, float ai, float& sr, float& si, float* BUs, unsigned* Sw, int lane) {
    const int l15 = lane & 15, quad = lane >> 4;
    bf16x8 uf = {0, 0, 0, 0, 0, 0, 0, 0};
    if (quad < 2) uf = *(const bf16x8*)(Z + (size_t)(row0 + l15) * 1440 + 1056 + g * 16 + quad * 8);
#pragma unroll
    for (int mt = 0; mt < 8; ++mt) {
        const f32x4 d = MFMA16(bbf[mt], uf, ((f32x4){0.f, 0.f, 0.f, 0.f}));
        *(f32x4*)&BUs[l15 * 132 + mt * 16 + quad * 4] = d;
    }
    WAVE_SYNC
#pragma unroll
    for (int i = 0; i < 16; ++i) {
        const int tt = REV ? 15 - i : i;
        const f2_t bq = *(const f2_t*)&BUs[tt * 132 + 2 * lane];
        const float nr = ar * sr - ai * si + bq[0], ni = ar * si + ai * sr + bq[1];
        sr = nr; si = ni;
        if (STORE) Sw[tt * 68 + lane] = pack2(sr, si);
    }
    WAVE_SYNC
}
DI void phase_ssm1(const Params& p, char* smem) {
    const int lane = TID_ & 63, wave = TID_ >> 6, gw = BID_ * 4 + wave, nw = GDIM_ * 4;
    const bf16_t* Z = (const bf16_t*)(p.ws + OFF_Z); float* SEND = (float*)(p.ws + OFF_OS + T_SEND);
    float* BUs = (float*)smem + wave * (16 * 132);
    for (int item = gw; item < 2 * 2 * 24 * 132; item += nw) {
        const int q = item % 132, g = (item / 132) % 24, dir = (item / (132 * 24)) & 1, b = item / (132 * 24 * 2);
        bf16x8 bbf[8]; ssm_load_bbf(p, dir * 24 + g, lane, bbf);
        const float* abar = (const float*)(p.ws + OFF_ABAR) + (size_t)((dir * 24 + g) * 64 + lane) * 2;
        const float ar = abar[0], ai = abar[1];
        float sr = 0.f, si = 0.f;
        for (int sb = 0; sb < 4; ++sb) {
            if (dir == 0) ssm_sub<false, false>(Z, b * TPB + q * 64 + sb * 16, g, bbf, ar, ai, sr, si, BUs, nullptr, lane);
            else ssm_sub<true, false>(Z, b * TPB + ssm_tok(1, q * 64 + sb * 16 + 15), g, bbf, ar, ai, sr, si, BUs, nullptr, lane);
        }
        float* dst = SEND + ((size_t)(((b * 2 + dir) * 24 + g) * 132 + q) * 64 + lane) * 2;
        dst[0] = sr; dst[1] = si;
    }
}
DI void phase_ssm2(const Params& p) {
    const int lane = TID_ & 63, gw = BID_ * 4 + (TID_ >> 6), nw = GDIM_ * 4;
    const float* SEND = (const float*)(p.ws + OFF_OS + T_SEND); float* CARRY = (float*)(p.ws + OFF_OS + T_CARRY);
    for (int item = gw; item < 96; item += nw) {
        const int dg = item % 48;
        const float* a64 = (const float*)(p.ws + OFF_A64) + (size_t)(dg * 64 + lane) * 2;
        const float ar = a64[0], ai = a64[1];
        float sr = 0.f, si = 0.f;
        const size_t base = (size_t)item * 132;
#pragma unroll 12
        for (int q = 0; q < 132; ++q) {
            const size_t o = ((base + q) * 64 + lane) * 2;
            const float er = SEND[o], ei = SEND[o + 1];
            CARRY[o] = sr; CARRY[o + 1] = si;
            const float nr = ar * sr - ai * si + er, ni = ar * si + ai * sr + ei;
            sr = nr; si = ni;
        }
    }
}
template <int DIR>
DI void ssm3_dir(const Params& p, const bf16_t* __restrict__ Z, const float* __restrict__ CARRY, const bf16_t* __restrict__ CXT, int b, int g, int c, int lane,
                 f32x4 (&acc)[4], float* BUs, unsigned* Sw) {
    const int l15 = lane & 15, quad = lane >> 4;
    bf16x8 bbf[8]; ssm_load_bbf(p, DIR * 24 + g, lane, bbf);
    const float* abar = (const float*)(p.ws + OFF_ABAR) + (size_t)((DIR * 24 + g) * 64 + lane) * 2;
    const float ar = abar[0], ai = abar[1];
    bf16x8 cf[4];
#pragma unroll
    for (int ks = 0; ks < 4; ++ks) cf[ks] = *(const bf16x8*)(CXT + (size_t)((DIR * 24 + g) * 16 + l15) * 128 + ks * 32 + quad * 8);
    const int q = DIR == 0 ? c : (c < 4 ? 3 - c : 135 - c);
    const float* cp = CARRY + ((size_t)(((b * 2 + DIR) * 24 + g) * 132 + q) * 64 + lane) * 2;
    float sr = cp[0], si = cp[1];
#pragma unroll
    for (int subi = 0; subi < 4; ++subi) {
        constexpr bool REV = DIR == 1;
        const int sub = REV ? 3 - subi : subi;
        ssm_sub<REV, true>(Z, b * TPB + c * 64 + sub * 16, g, bbf, ar, ai, sr, si, BUs, Sw, lane);
#pragma unroll
        for (int ks = 0; ks < 4; ++ks) {
            const bf16x8 sf = *(const bf16x8*)((const char*)Sw + l15 * 272 + ks * 64 + quad * 16);
            acc[sub] = MFMA16(cf[ks], sf, acc[sub]);
        }
        WAVE_SYNC
    }
}
DI void phase_ssm3(const Params& p, int l, char* smem) {
    const int lane = TID_ & 63, wave = TID_ >> 6, l15 = lane & 15, quad = lane >> 4;
    const int gw = BID_ * 4 + wave, nw = GDIM_ * 4;
    const bf16_t* Z = (const bf16_t*)(p.ws + OFF_Z); const float* CARRY = (const float*)(p.ws + OFF_OS + T_CARRY);
    bf16_t* YG = (bf16_t*)(p.ws + OFF_T + T_YG);
    const bf16_t* CXT = (const bf16_t*)(p.ws + OFF_CXT);
    const float* dvec = p.in[20] + l * 384;
    float* BUs = (float*)smem + wave * (16 * 132);
    unsigned* Sw = (unsigned*)(smem + 4 * 16 * 132 * 4) + wave * (16 * 68);
    for (int item = gw; item < 2 * 24 * 132; item += nw) {
        const int c = item % 132, g = (item / 132) % 24, b = item / (132 * 24);
        f32x4 acc[4];
#pragma unroll
        for (int i = 0; i < 4; ++i) acc[i] = (f32x4){0.f, 0.f, 0.f, 0.f};
        ssm3_dir<0>(p, Z, CARRY, CXT, b, g, c, lane, acc, BUs, Sw);
        ssm3_dir<1>(p, Z, CARRY, CXT, b, g, c, lane, acc, BUs, Sw);
#pragma unroll
        for (int sub = 0; sub < 4; ++sub) {
            const int row = b * TPB + c * 64 + sub * 16 + l15, ch = g * 16 + quad * 4;
            const uint2 zw = *(const uint2*)(Z + (size_t)row * 1440 + 1056 + ch);
            const f32x4 d = *(const f32x4*)(dvec + ch);
            float y[4] = {acc[sub][0] + d[0] * bflo(zw.x), acc[sub][1] + d[1] * bfhi(zw.x), acc[sub][2] + d[2] * bflo(zw.y), acc[sub][3] + d[3] * bfhi(zw.y)};
#pragma unroll
            for (int j = 0; j < 4; ++j) {
                const float x = y[j], inner = 0.7978845608028654f * (x + 0.044715f * x * x * x);
                const float th = 1.f - 2.f / (__expf(2.f * inner) + 1.f);
                y[j] = 0.5f * x * (1.f + th);
            }
            st_bf4(YG + (size_t)row * 384 + ch, y[0], y[1], y[2], y[3]);
        }
    }
}

DI void run_phase(const Params& p, int ph, char* smem, char* smem8) {
    if (ph == NPH - 1) { phase_final(p); return; }
    const int l = ph / NPH_LAYER;
#ifdef PH_ONLY
    const int k = PH_ONLY; if (ph % NPH_LAYER != PH_ONLY) return;
#else
    const int k = ph % NPH_LAYER;
#endif
#ifdef PH_SKIP
    if (k == PH_SKIP) return;
#endif
#ifdef PH_SKIP2
    if (k == PH_SKIP2) return;
#endif
    switch (k) {
        case 0: phase_prep(p, l, smem); break;
        case 1: phase_norm(p, l, 0); break;
        case 2: phase_gemm_z(p, smem8); break;
        case 3: phase_znorm(p, l); break;
        case 4: phase_gemm_qkv(p, smem); break;
        case 5: phase_four1(p, l, smem); phase_ssm1(p, smem); break;
        case 6: phase_ssm2(p); phase_four2(p, l, smem); break;
        case 7: phase_ssm3(p, l, smem); __syncthreads(); phase_attn(p, l, smem); break;
        case 8: phase_gemm_glu(p, l, smem); break;
        case 9: phase_merge(p, l, smem, smem8); break;
        case 10: phase_gemm_res(p, l, 0, smem, smem8); break;
        case 11: phase_norm(p, l, 1); break;
        case 12: phase_mlp1(p, l, smem, smem8); break;
        default: phase_gemm_res(p, l, 1, smem, smem8); break;
    }
}

#define XB_TMO      128
#define XB_XCNT(j)  (256  + 64 * (j))
#define XB_XSUB(j)  (1280 + 64 * (j))
#define XB_XGEN(j)  (2304 + 64 * (j))
#define XB_TOP      3328
#define XB_TOPGEN   3392
#define XCD_BAR_WORDS 3456
#define XB_SPIN_CAP (1u << 22)
#define LAS __attribute__((address_space(3)))
DI unsigned xb_ld(unsigned* p) { return __hip_atomic_load(p, __ATOMIC_RELAXED, __HIP_MEMORY_SCOPE_AGENT); }
DI unsigned xb_add(unsigned* p, unsigned v) { return __hip_atomic_fetch_add(p, v, __ATOMIC_RELAXED, __HIP_MEMORY_SCOPE_AGENT); }
DI unsigned xb_xcc_id() { return (unsigned)__builtin_amdgcn_s_getreg((3 << 11) | 20) & 0xFu; }
#define XB_SPIN(cond, bar) do { unsigned _sp = 0; while (cond) { __builtin_amdgcn_s_sleep(1); \
    if ((++_sp & 255u) == 0u) { if (xb_ld(&(bar)[XB_TMO])) break; if (_sp > XB_SPIN_CAP) { atomicAdd(&(bar)[XB_TMO], 1u); break; } } } } while (0)
struct XcdBarrier { unsigned* bar; unsigned x; volatile LAS unsigned* st; };
DI XcdBarrier xcd_barrier_post(unsigned* bar, volatile LAS unsigned* st) {
    XcdBarrier b; b.bar = bar; b.x = xb_xcc_id(); b.st = st;
    if (threadIdx.x == 0) (void)xb_add(&bar[XB_XCNT(b.x)], 1u);
    return b;
}
DI void xcd_barrier_complete(unsigned* bar, unsigned x, unsigned& nloc, unsigned& nx) {
    const unsigned G = gridDim.x * gridDim.y * gridDim.z;
    unsigned sum, cnt, mine, sp = 0u;
    for (;;) {
        sum = 0u; cnt = 0u; mine = 0u;
#pragma unroll
        for (unsigned j = 0; j < 16; ++j) { const unsigned c = xb_ld(&bar[XB_XCNT(j)]); sum += c; cnt += (c > 0u) ? 1u : 0u; mine = (j == x) ? c : mine; }
        if (sum == G) break;
        __builtin_amdgcn_s_sleep(1);
        if ((++sp & 255u) == 0u) { if (xb_ld(&bar[XB_TMO])) break; if (sp > XB_SPIN_CAP) { atomicAdd(&bar[XB_TMO], 1u); break; } }
    }
    nloc = mine > 0u ? mine : 1u; nx = cnt > 0u ? cnt : 1u;
}
DI void xcd_barrier(const XcdBarrier& b) {
    asm volatile("s_waitcnt vmcnt(0)" ::: "memory");
    __syncthreads();
    if (threadIdx.x == 0) {
        size_t zb_ = 0; asm volatile("" : "+s"(zb_));
        unsigned* bar = b.bar + zb_;
        __builtin_amdgcn_s_waitcnt(0);
        unsigned nloc = b.st[0], nx = b.st[1];
        if (nloc == 0u) { xcd_barrier_complete(bar, b.x, nloc, nx); b.st[0] = nloc; b.st[1] = nx; }
        const unsigned old = xb_add(&bar[XB_XSUB(b.x)], 1u);
        const unsigned gen = old / nloc;
        if (old + 1u == (gen + 1u) * nloc) {
            __builtin_amdgcn_fence(__ATOMIC_RELEASE, "agent");
            asm volatile("s_waitcnt vmcnt(0)" ::: "memory");
            const unsigned og = xb_add(&bar[XB_TOP], 1u);
            const unsigned tg = og / nx;
            if (og + 1u == (tg + 1u) * nx) xb_add(&bar[XB_TOPGEN], 1u);
            else XB_SPIN(xb_ld(&bar[XB_TOPGEN]) == tg, bar);
            __builtin_amdgcn_fence(__ATOMIC_ACQUIRE, "agent");
            xb_add(&bar[XB_XGEN(b.x)], 1u);
            asm volatile("s_waitcnt vmcnt(0)" ::: "memory");
        } else {
            XB_SPIN(xb_ld(&bar[XB_XGEN(b.x)]) == gen, bar);
            __builtin_amdgcn_fence(__ATOMIC_ACQUIRE, "agent");
            asm volatile("s_waitcnt vmcnt(0)" ::: "memory");
        }
    }
    __syncthreads();
}
__global__ void __launch_bounds__(512, 2) mk_fwd(Params p) {
    __shared__ __attribute__((aligned(16))) char smem[SMEM_BYTES];
    __shared__ uint4 xb_words;
    if (threadIdx.x == 0) xb_words = make_uint4(0u, 0u, 0u, 0u);
    __syncthreads();
    XcdBarrier xb = xcd_barrier_post((unsigned*)(p.ws + OFF_BAR), (volatile LAS unsigned*)&xb_words);
    for (int ph = p.lo; ph < p.hi; ++ph) {
        size_t zoff_ = 0; asm volatile("" : "+s"(zoff_));
        Params q = p; q.ws = p.ws + zoff_; q.out = p.out + zoff_;
        run_phase(q, ph, smem + HALF_ * SMEM_HALF, smem);
        if (ph + 1 < p.hi) {
            if (ph == p.lo) cg::this_grid().sync();
            else xcd_barrier(xb);
        }
    }
}

extern "C" void kernel_launch(void* const* d_in, const int* in_sizes, int n_in, void* d_out, int out_size, void* d_ws, size_t ws_size, hipStream_t stream) {
    static int grid_blocks = 0;
    if (!grid_blocks) {
        int dev = 0, cus = 0, per_cu = 0;
        hipGetDevice(&dev);
        hipDeviceGetAttribute(&cus, hipDeviceAttributeMultiprocessorCount, dev);
        hipOccupancyMaxActiveBlocksPerMultiprocessor(&per_cu, (const void*)mk_fwd, 512, 0);
        if (per_cu > 1) per_cu = 1;
        if (per_cu < 1) per_cu = 1;
        grid_blocks = cus * per_cu;
    }
    Params p{};
    for (int i = 0; i < 32; ++i) p.in[i] = (const float*)d_in[i];
    p.out = (float*)d_out; p.ws = (char*)d_ws;
#if MULTI_LAUNCH
    for (int ph = 0; ph < NPH; ++ph) {
        p.lo = ph; p.hi = ph + 1;
        hipLaunchKernelGGL(mk_fwd, dim3(grid_blocks), dim3(512), 0, stream, p);
    }
#else
    p.lo = 0; p.hi = NPH;
    hipMemsetAsync((char*)d_ws + OFF_BAR, 0, 16384, stream);
    void* args[] = {&p};
    hipError_t e = hipLaunchCooperativeKernel((const void*)mk_fwd, dim3(grid_blocks), dim3(512), args, 0, stream);
    if (e != hipSuccess) fprintf(stderr, "cooperative launch failed: %s (grid %d)\n", hipGetErrorString(e), grid_blocks);
#endif
}
```

```cpp
#include <hip/hip_runtime.h>
#include <hip/hip_cooperative_groups.h>
#include <stdint.h>
#include <stdio.h>
namespace cg = cooperative_groups;

#ifndef MULTI_LAUNCH
#define MULTI_LAUNCH 0
#endif

typedef unsigned short bf16_t;
typedef short bf16x8 __attribute__((ext_vector_type(8)));
typedef float f32x4 __attribute__((ext_vector_type(4)));
typedef unsigned u32x4 __attribute__((ext_vector_type(4)));
#define DI __device__ __forceinline__
#define BID_ ({ int z_ = 0; asm volatile("" : "+s"(z_)); (int)blockIdx.x * 2 + HALF_ + z_; })
#define GDIM_ ({ int z_ = 0; asm volatile("" : "+s"(z_)); (int)gridDim.x * 2 + z_; })
#define HALF_ ({ int zh_ = 0; asm volatile("" : "+s"(zh_)); (int)__builtin_amdgcn_readfirstlane((int)(threadIdx.x >> 8) + zh_); })
#define TID_ ({ int z_ = 0; asm volatile("" : "+s"(z_)); (int)(threadIdx.x & 255) + z_; })
#define TID8_ ({ int z_ = 0; asm volatile("" : "+s"(z_)); (int)threadIdx.x + z_; })
#define PBID_ ({ int z_ = 0; asm volatile("" : "+s"(z_)); (int)blockIdx.x + z_; })
#define PGDIM_ ({ int z_ = 0; asm volatile("" : "+s"(z_)); (int)gridDim.x + z_; })
#define MFMA16(a, b, c) __builtin_amdgcn_mfma_f32_16x16x32_bf16((a), (b), (c), 0, 0, 0)

constexpr int TPB = 8448, R = 16896, SEQ = 8192, CTX = 256;
constexpr int NPH_LAYER = 14, NPH = 2 * NPH_LAYER + 1;
constexpr size_t al256(size_t x) { return (x + 255) & ~(size_t)255; }
constexpr int LD1 = 1088, LD4 = 4160;
constexpr size_t WO_IN = 0, WO_GATE = WO_IN + 1440 * LD1, WO_UQ = WO_GATE + 3072 * LD1, WO_K = WO_UQ + 768 * 384,
                 WO_V = WO_K + 512 * 256, WO_GLU = WO_V + 512 * 256, WO_BA = WO_GLU + 384 * 384, WO_BF = WO_BA + 1024 * 512,
                 WO_BS = WO_BF + 1024 * 384, WO_OUT = WO_BS + 1024 * 384, WO_1 = WO_OUT + 1024 * LD1, WO_2 = WO_1 + 4096 * LD1,
                 WO_END = WO_2 + 1024 * LD4;
constexpr size_t OFF_H = 0;
constexpr size_t OFF_W = OFF_H + (size_t)R * LD1 * 2;
constexpr size_t OFF_XC = OFF_W + WO_END * 2;
constexpr size_t OFF_MOD = OFF_XC + 512 * 1024 * 4;
constexpr size_t OFF_ROPE = OFF_MOD + al256(2 * 3 * 6144 * 4);
constexpr size_t OFF_TW8192 = OFF_ROPE + 2 * 8192 * 16 * 4;
constexpr size_t OFF_TW256 = OFF_TW8192 + 8192 * 2 * 4;
constexpr size_t OFF_T0 = OFF_TW256 + 256 * 2 * 4;
constexpr size_t OFF_T1L = OFF_T0 + 128 * 64 * 2;
constexpr size_t OFF_T1C = OFF_T1L + 256 * 256 * 2;
constexpr size_t OFF_T2L = OFF_T1C + 32 * 32 * 2;
constexpr size_t OFF_T2C = OFF_T2L + 64 * 128 * 2;
constexpr size_t OFF_ABAR = OFF_T2C + 16 * 32 * 2;
constexpr size_t OFF_A64 = OFF_ABAR + 2 * 24 * 64 * 2 * 4;
constexpr size_t OFF_BBAR = OFF_A64 + 2 * 24 * 64 * 2 * 4;
constexpr size_t OFF_CXT = OFF_BBAR + 2 * 24 * 64 * 32 * 4;
constexpr size_t OFF_Z = al256(OFF_CXT + 2 * 24 * 16 * 128 * 2);
constexpr size_t OFF_T = OFF_Z + (size_t)R * 1440 * 2;
constexpr size_t SZ_T = 25952256;
constexpr size_t OFF_Q = OFF_T + SZ_T;
constexpr size_t OFF_K = OFF_Q + (size_t)R * 768 * 2;
constexpr size_t OFF_VT = OFF_K + (size_t)R * 768 * 2;
constexpr size_t OFF_OA = OFF_VT + (size_t)2 * 8 * 64 * TPB * 2;
constexpr size_t OFF_OF = OFF_OA + (size_t)R * 512 * 2;
constexpr size_t OFF_OS = OFF_OF + (size_t)R * 384 * 2;
constexpr size_t OFF_END = OFF_OS + (size_t)R * 384 * 2;
constexpr size_t OFF_BAR = OFF_END;
static_assert(OFF_BAR + 16384 <= 268435456, "workspace too large");
constexpr size_t T_QIN = 0, T_CKV = (size_t)R * 384 * 2;
constexpr size_t T_F1L = 0, T_F1C = (size_t)2 * 8192 * 768 * 2;
constexpr size_t T_SEND = 0, T_CARRY = (size_t)2 * 2 * 24 * 132 * 64 * 2 * 4, T_YG = 2 * T_CARRY;
static_assert(T_YG + (size_t)R * 384 * 2 <= SZ_T && T_F1C + (size_t)2 * 256 * 768 * 2 <= SZ_T, "T region");
static_assert((size_t)R * LD4 * 2 <= OFF_OA - OFF_Z, "U alias");

constexpr int SMEM_HALF = 69632, SMEM_BYTES = 2 * SMEM_HALF;

struct Params { const float* in[32]; float* out; char* ws; int lo, hi; };

DI bf16_t f2bf(float x) { unsigned u = __float_as_uint(x); u += 0x7fffu + ((u >> 16) & 1u); return (bf16_t)(u >> 16); }
DI float bf2f(bf16_t h) { return __uint_as_float(((unsigned)h) << 16); }
typedef __bf16 bf2_t __attribute__((ext_vector_type(2)));
typedef float f2_t __attribute__((ext_vector_type(2)));
DI unsigned pack2(float a, float b) { f2_t v = {a, b}; bf2_t r = __builtin_convertvector(v, bf2_t); return __builtin_bit_cast(unsigned, r); }
DI float bflo(unsigned w) { return __uint_as_float(w << 16); }
DI float bfhi(unsigned w) { return __uint_as_float(w & 0xffff0000u); }
DI float max3f(float a, float b, float c) { float r; asm("v_max3_f32 %0, %1, %2, %3" : "=v"(r) : "v"(a), "v"(b), "v"(c)); return r; }
DI float sigmoidf_(float x) { return 1.f / (1.f + __expf(-x)); }
DI float shx(float v, int mask) {
    unsigned z_ = 0; asm volatile("" : "+s"(z_));
    const int lane = (int)__builtin_amdgcn_mbcnt_hi(~0u, __builtin_amdgcn_mbcnt_lo(~0u, z_));
    return __int_as_float(__builtin_amdgcn_ds_bpermute((lane ^ mask) << 2, __float_as_int(v)));
}
DI float wave_sum(float v) {
#pragma unroll
    for (int o = 32; o >= 1; o >>= 1) v += shx(v, o);
    return v;
}
DI float* xptr(const Params& p, bool orig, int row) {
    const int b = row / TPB, t = row - b * TPB;
    if (t < CTX) { float* base = orig ? (float*)p.in[2] : (float*)(p.ws + OFF_XC); return base + (size_t)(b * CTX + t) * 1024; }
    float* base = orig ? (float*)p.in[0] : p.out; return base + (size_t)(b * SEQ + t - CTX) * 1024;
}
DI int srow_of(int row) { const int b = row / TPB, t = row - b * TPB; return t < CTX ? 2 : b; }

DI void gemm_main(f32x4 (&acc)[4][4], const bf16_t* __restrict__ A, int lda, int arows, const bf16_t* __restrict__ B, int ldb, int brows,
                  int K, int row0, int col0, char* smem) {
    const int tid = TID_, lane = tid & 63, wave = tid >> 6, l15 = lane & 15, quad = lane >> 4, wm = wave >> 1, wn = wave & 1;
    __builtin_amdgcn_sched_barrier(0);
    char* As = smem;
    char* Bs = smem + 32768;
#pragma unroll
    for (int i = 0; i < 4; ++i)
#pragma unroll
        for (int j = 0; j < 4; ++j) acc[i][j] = (f32x4){0.f, 0.f, 0.f, 0.f};
    const int sb = lane * 16, swz = sb ^ (((sb >> 9) & 1) << 5), sr = swz >> 6, sk = (swz & 63) >> 1;
    const bf16_t* pa[4]; const bf16_t* pb[4];
#pragma unroll
    for (int i = 0; i < 4; ++i) {
        const int st = wave + 4 * i, rr = (st >> 1) * 16 + sr, kk = (st & 1) * 32 + sk;
        pa[i] = A + (size_t)min(row0 + rr, arows - 1) * lda + kk;
        pb[i] = B + (size_t)min(col0 + rr, brows - 1) * ldb + kk;
    }
    const int wofs = wave * 1024 + lane * 16;
    const int lo = (l15 * 64 + quad * 16) ^ ((l15 >> 3) << 5);
    u32x4 ra[4], rb[4];
#define G_ISSUE(k0) _Pragma("unroll") for (int i = 0; i < 4; ++i) { ra[i] = *(const u32x4*)(pa[i] + (k0)); rb[i] = *(const u32x4*)(pb[i] + (k0)); }
#define G_WRITE(buf) _Pragma("unroll") for (int i = 0; i < 4; ++i) { *(u32x4*)(As + (buf)*16384 + i * 4096 + wofs) = ra[i]; *(u32x4*)(Bs + (buf)*16384 + i * 4096 + wofs) = rb[i]; }
    const int KT = K >> 6;
    G_ISSUE(0)
    G_WRITE(0)
    if (KT > 1) { G_ISSUE(64) }
    __syncthreads();
    for (int kt = 0; kt < KT; ++kt) {
        const int cur = kt & 1;
#pragma unroll
        for (int ks = 0; ks < 2; ++ks) {
            if (ks == 1) {
                if (kt + 1 < KT) { G_WRITE(cur ^ 1) }
                if (kt + 2 < KT) { G_ISSUE((kt + 2) * 64) }
            }
            bf16x8 af[4], bfr[4];
#pragma unroll
            for (int mi = 0; mi < 4; ++mi) af[mi] = *(const bf16x8*)(As + cur * 16384 + ((wm * 4 + mi) * 2 + ks) * 1024 + lo);
#pragma unroll
            for (int ni = 0; ni < 4; ++ni) bfr[ni] = *(const bf16x8*)(Bs + cur * 16384 + ((wn * 4 + ni) * 2 + ks) * 1024 + lo);
#pragma unroll
            for (int mi = 0; mi < 4; ++mi)
#pragma unroll
                for (int ni = 0; ni < 4; ++ni) acc[mi][ni] = MFMA16(bfr[ni], af[mi], acc[mi][ni]);
            __builtin_amdgcn_sched_barrier(0);
        }
        __syncthreads();
    }
#undef G_ISSUE
#undef G_WRITE
}
DI void gemm_main2(f32x4 (&acc)[8][4], const bf16_t* __restrict__ A, int lda, int arows, const bf16_t* __restrict__ B, int ldb, int brows,
                   int K, int row0, int col0, char* smem) {
    const int tid = TID_, lane = tid & 63, wave = tid >> 6, l15 = lane & 15, quad = lane >> 4, wm = wave >> 1, wn = wave & 1;
    __builtin_amdgcn_sched_barrier(0);
    char* As = smem;
    char* Bs = smem + 32768;
#pragma unroll
    for (int i = 0; i < 8; ++i)
#pragma unroll
        for (int j = 0; j < 4; ++j) acc[i][j] = (f32x4){0.f, 0.f, 0.f, 0.f};
    const int sb = lane * 16, swz = sb ^ (((sb >> 9) & 1) << 5), sr = swz >> 6, sk = (swz & 63) >> 1;
    const bf16_t* pa[4]; const bf16_t* pb[2];
#pragma unroll
    for (int i = 0; i < 4; ++i) pa[i] = A + (size_t)min(row0 + (wave + 4 * i) * 16 + sr, arows - 1) * lda + sk;
#pragma unroll
    for (int i = 0; i < 2; ++i) pb[i] = B + (size_t)min(col0 + (wave + 4 * i) * 16 + sr, brows - 1) * ldb + sk;
    const int wofs = wave * 1024 + lane * 16;
    const int lo = (l15 * 64 + quad * 16) ^ ((l15 >> 3) << 5);
    u32x4 ra[4], rb[2];
#define G_ISSUE(k0) { _Pragma("unroll") for (int i = 0; i < 4; ++i) ra[i] = *(const u32x4*)(pa[i] + (k0)); _Pragma("unroll") for (int i = 0; i < 2; ++i) rb[i] = *(const u32x4*)(pb[i] + (k0)); }
#define G_WRITE(buf) { _Pragma("unroll") for (int i = 0; i < 4; ++i) *(u32x4*)(As + (buf)*16384 + i * 4096 + wofs) = ra[i]; _Pragma("unroll") for (int i = 0; i < 2; ++i) *(u32x4*)(Bs + (buf)*8192 + i * 4096 + wofs) = rb[i]; }
    const int KT = K >> 5;
    G_ISSUE(0)
    G_WRITE(0)
    if (KT > 1) G_ISSUE(32)
    __syncthreads();
    for (int kt = 0; kt < KT; ++kt) {
        const int cur = kt & 1;
        bf16x8 bfr[4];
#pragma unroll
        for (int ni = 0; ni < 4; ++ni) bfr[ni] = *(const bf16x8*)(Bs + cur * 8192 + (wn * 4 + ni) * 1024 + lo);
#pragma unroll
        for (int mi = 0; mi < 4; ++mi) {
            const bf16x8 af = *(const bf16x8*)(As + cur * 16384 + (wm * 8 + mi) * 1024 + lo);
#pragma unroll
            for (int ni = 0; ni < 4; ++ni) acc[mi][ni] = MFMA16(bfr[ni], af, acc[mi][ni]);
        }
        __builtin_amdgcn_sched_barrier(0);
        if (kt + 1 < KT) G_WRITE(cur ^ 1)
        if (kt + 2 < KT) G_ISSUE((kt + 2) * 32)
#pragma unroll
        for (int mi = 4; mi < 8; ++mi) {
            const bf16x8 af = *(const bf16x8*)(As + cur * 16384 + (wm * 8 + mi) * 1024 + lo);
#pragma unroll
            for (int ni = 0; ni < 4; ++ni) acc[mi][ni] = MFMA16(bfr[ni], af, acc[mi][ni]);
        }
        __syncthreads();
    }
#undef G_ISSUE
#undef G_WRITE
}
#define EPI2_ROW(mi) (row0 + wm_ * 128 + (mi)*16 + l15_)
DI void gemm_main3(f32x4 (&acc)[8][4], const bf16_t* __restrict__ A, int lda, int arows, const bf16_t* __restrict__ B, int ldb, int brows,
                   int K, int row0, int col0, char* smem8) {
    const int tid = TID8_, lane = tid & 63, wave = tid >> 6, l15 = lane & 15, quad = lane >> 4, wr = wave >> 2, wc = wave & 3;
    __builtin_amdgcn_sched_barrier(0);
    char* As = smem8;
    char* Bs = smem8 + 65536;
#pragma unroll
    for (int i = 0; i < 8; ++i)
#pragma unroll
        for (int j = 0; j < 4; ++j) acc[i][j] = (f32x4){0.f, 0.f, 0.f, 0.f};
    const int sb = lane * 16, swz = sb ^ (((sb >> 9) & 1) << 5), sr = swz >> 6, sk = (swz & 63) >> 1;
    const bf16_t* pa[4]; const bf16_t* pb[4];
#pragma unroll
    for (int i = 0; i < 4; ++i) {
        const int st = wave + 8 * i, rr = (st >> 1) * 16 + sr, kk = (st & 1) * 32 + sk;
        pa[i] = A + (size_t)min(row0 + rr, arows - 1) * lda + kk;
        pb[i] = B + (size_t)min(col0 + rr, brows - 1) * ldb + kk;
    }
    const int wofs = wave * 1024 + lane * 16;
    const int lo = (l15 * 64 + quad * 16) ^ ((l15 >> 3) << 5);
    u32x4 ra[4], rb[4];
#define G_ISSUE(k0) { _Pragma("unroll") for (int i = 0; i < 4; ++i) { ra[i] = *(const u32x4*)(pa[i] + (k0)); rb[i] = *(const u32x4*)(pb[i] + (k0)); } }
#define G_WRITE(buf) { _Pragma("unroll") for (int i = 0; i < 4; ++i) { *(u32x4*)(As + (buf)*32768 + i * 8192 + wofs) = ra[i]; *(u32x4*)(Bs + (buf)*32768 + i * 8192 + wofs) = rb[i]; } }
    const int KT = K >> 6;
    G_ISSUE(0)
    G_WRITE(0)
    if (KT > 1) G_ISSUE(64)
    __syncthreads();
    for (int kt = 0; kt < KT; ++kt) {
        const int cur = kt & 1;
#pragma unroll
        for (int ks = 0; ks < 2; ++ks) {
            if (ks == 1) {
                if (kt + 1 < KT) G_WRITE(cur ^ 1)
                if (kt + 2 < KT) G_ISSUE((kt + 2) * 64)
            }
            bf16x8 bfr[4];
#pragma unroll
            for (int ni = 0; ni < 4; ++ni) bfr[ni] = *(const bf16x8*)(Bs + cur * 32768 + ((wc * 4 + ni) * 2 + ks) * 1024 + lo);
#pragma unroll
            for (int mi = 0; mi < 8; ++mi) {
                const bf16x8 af = *(const bf16x8*)(As + cur * 32768 + ((wr * 8 + mi) * 2 + ks) * 1024 + lo);
#pragma unroll
                for (int ni = 0; ni < 4; ++ni) acc[mi][ni] = MFMA16(bfr[ni], af, acc[mi][ni]);
            }
            __builtin_amdgcn_sched_barrier(0);
        }
        __syncthreads();
    }
#undef G_ISSUE
#undef G_WRITE
}
#define EPI8_VARS const int tid8_ = TID8_, lane8_ = tid8_ & 63, wave8_ = tid8_ >> 6, l15e_ = lane8_ & 15, quade_ = lane8_ >> 4, wr_ = wave8_ >> 2, wc_ = wave8_ & 3;
#define EPI8_ROW(mi) (row0 + wr_ * 128 + (mi)*16 + l15e_)
#define EPI8_COL(ni) (col0 + wc_ * 64 + (ni)*16 + quade_ * 4)
#define EPI_VARS const int tid_ = TID_, lane_ = tid_ & 63, wave_ = tid_ >> 6, l15_ = lane_ & 15, quad_ = lane_ >> 4, wm_ = wave_ >> 1, wn_ = wave_ & 1; (void)l15_; (void)quad_; (void)wm_; (void)wn_;
#define EPI_ROW(mi) (row0 + wm_ * 64 + (mi)*16 + l15_)
#define EPI_COL(ni) (col0 + wn_ * 64 + (ni)*16 + quad_ * 4)
DI void st_bf4(bf16_t* dst, float a, float b, float c, float d) { uint2 w; w.x = pack2(a, b); w.y = pack2(c, d); *(uint2*)dst = w; }
template <int MI>
DI void stage_tile_bf16(const f32x4 (&acc)[MI][4], char* smem, bf16_t* __restrict__ dst, int ld, int row0, int col0, int ncols, bool kmap = false) {
    const int tid = TID_, lane = tid & 63, wave = tid >> 6, l15 = lane & 15, quad = lane >> 4, wm = wave >> 1, wn = wave & 1;
    bf16_t* T = (bf16_t*)smem;
#pragma unroll
    for (int mi = 0; mi < MI; ++mi)
#pragma unroll
        for (int ni = 0; ni < 4; ++ni) {
            uint2 w; w.x = pack2(acc[mi][ni][0], acc[mi][ni][1]); w.y = pack2(acc[mi][ni][2], acc[mi][ni][3]);
            *(uint2*)&T[(wm * (MI * 16) + mi * 16 + l15) * 136 + wn * 64 + ni * 16 + quad * 4] = w;
        }
    __syncthreads();
#pragma unroll
    for (int i = 0; i < MI * 2; ++i) {
        const int c = tid + 256 * i, r = c >> 4, part = c & 15;
        const int cc_ = col0 + part * 8, dc_ = kmap ? (cc_ >> 6) * 96 + (cc_ & 63) : cc_;
        if (cc_ < ncols) *(u32x4*)(dst + (size_t)(row0 + r) * ld + dc_) = *(const u32x4*)&T[r * 136 + part * 8];
    }
    __syncthreads();
}

DI void stage_tile8(const f32x4 (&acc)[8][4], char* smem8, bf16_t* __restrict__ dst, int ld, int row0, int col0, int ncols) {
    const int tid = TID8_, lane = tid & 63, wave = tid >> 6, l15 = lane & 15, quad = lane >> 4, wr = wave >> 2, wc = wave & 3;
    bf16_t* T = (bf16_t*)smem8;
#pragma unroll
    for (int mi = 0; mi < 8; ++mi)
#pragma unroll
        for (int ni = 0; ni < 4; ++ni) {
            uint2 w; w.x = pack2(acc[mi][ni][0], acc[mi][ni][1]); w.y = pack2(acc[mi][ni][2], acc[mi][ni][3]);
            *(uint2*)&T[(wr * 128 + mi * 16 + l15) * 264 + wc * 64 + ni * 16 + quad * 4] = w;
        }
    __syncthreads();
#pragma unroll
    for (int i = 0; i < 16; ++i) {
        const int c = tid + 512 * i, r = c >> 5, part = c & 31;
        if (col0 + part * 8 < ncols) *(u32x4*)(dst + (size_t)(row0 + r) * ld + col0 + part * 8) = *(const u32x4*)&T[r * 264 + part * 8];
    }
    __syncthreads();
}
DI void conv_job(const float* __restrict__ W, int K, int N, int ldw, int mode, bf16_t* __restrict__ Wt, int ldo, char* smem) {
    const int tid = TID_;
    bf16_t* T = (bf16_t*)smem;
    const int tn = N >> 5, ntiles = (K >> 6) * tn;
    const int kk = tid >> 3, n4 = (tid & 7) * 4;
    const int bid = BID_, gstep = GDIM_;
    f32x4 v0 = {0.f, 0.f, 0.f, 0.f}, v1 = v0;
    auto src_of = [&](int t) -> const float* {
        const int k0 = (t / tn) * 64, nn = (t % tn) * 32 + n4;
        const int sc = mode == 0 ? nn : ((nn >> 6) * 128 + (nn & 63) + (mode == 2 ? 64 : 0));
        return W + (size_t)(k0 + kk) * ldw + sc;
    };
    if (bid < ntiles) { const float* sp = src_of(bid); v0 = *(const f32x4*)sp; v1 = *(const f32x4*)(sp + (size_t)32 * ldw); }
    for (int t = bid; t < ntiles; t += gstep) {
        f32x4 w0 = v0, w1 = v1;
        if (t + gstep < ntiles) { const float* sp = src_of(t + gstep); v0 = *(const f32x4*)sp; v1 = *(const f32x4*)(sp + (size_t)32 * ldw); }
        const int k0 = (t / tn) * 64, n0 = (t % tn) * 32;
#pragma unroll
        for (int j = 0; j < 4; ++j) { T[(n4 + j) * 72 + kk] = f2bf(w0[j]); T[(n4 + j) * 72 + kk + 32] = f2bf(w1[j]); }
        __syncthreads();
        const int n = tid >> 3, kq = (tid & 7) * 8;
        *(u32x4*)(Wt + (size_t)(n0 + n) * ldo + k0 + kq) = *(const u32x4*)&T[n * 72 + kq];
        __syncthreads();
    }
}
DI void gen_t1(bf16_t* T, int N1, int gtid, int gthreads) {
    const int S = 2 * N1;
    for (int i = gtid; i < S * S; i += gthreads) {
        const int m2 = i / S, kk = i % S, k1 = m2 >> 1, ro = m2 & 1, n1 = kk >> 1, ri = kk & 1;
        const int q = (n1 * k1) % N1; float s, c; sincospif(2.f * (float)q / (float)N1, &s, &c);
        const float v = ro == 0 ? (ri == 0 ? c : s) : (ri == 0 ? -s : c);
        T[i] = f2bf(v);
    }
}
DI void gen_t2(bf16_t* T, int N2, int gtid, int gthreads) {
    const int S = 2 * N2;
    for (int i = gtid; i < N2 * S; i += gthreads) {
        const int k2 = i / S, kk = i % S, n2 = kk >> 1, ri = kk & 1;
        const int q = (n2 * k2) % N2; float s, c; sincospif(2.f * (float)q / (float)N2, &s, &c);
        T[i] = f2bf(ri == 0 ? c : s);
    }
}
DI void phase_prep(const Params& p, int l, char* smem) {
    const int tid = TID_, lane = tid & 63, wave = tid >> 6;
    const int gtid = BID_ * 256 + tid, gthreads = GDIM_ * 256;
    char* ws = p.ws;
    if (l == 0) {
        float* sil = (float*)smem;
        float* red = sil + 3072;
        for (int item = BID_; item < 192; item += GDIM_) {
            const int ll = item / 96, cgp = item % 96;
            for (int i = tid; i < 3072; i += 256) {
                const int s = i >> 10, k = i & 1023;
                const float x = s < 2 ? p.in[1][s * 1024 + k] : p.in[3][k];
                sil[i] = x / (1.f + __expf(-x));
            }
            __syncthreads();
            const int col = cgp * 64 + lane;
            const float* wp = p.in[4] + (size_t)ll * 1024 * 6144 + col;
            float a0 = 0.f, a1 = 0.f, a2 = 0.f;
#pragma unroll 32
            for (int k = wave * 256; k < wave * 256 + 256; ++k) {
                const float w = wp[(size_t)k * 6144];
                a0 += sil[k] * w; a1 += sil[1024 + k] * w; a2 += sil[2048 + k] * w;
            }
            red[(wave * 3 + 0) * 64 + lane] = a0; red[(wave * 3 + 1) * 64 + lane] = a1; red[(wave * 3 + 2) * 64 + lane] = a2;
            __syncthreads();
            if (wave < 3) {
                const float v = red[(0 * 3 + wave) * 64 + lane] + red[(1 * 3 + wave) * 64 + lane] + red[(2 * 3 + wave) * 64 + lane] + red[(3 * 3 + wave) * 64 + lane];
                ((float*)(ws + OFF_MOD))[(size_t)(ll * 3 + wave) * 6144 + col] = v + p.in[5][ll * 6144 + col];
            }
            __syncthreads();
        }
        float* rc = (float*)(ws + OFF_ROPE); float* rs = rc + 8192 * 16;
        for (int i = gtid; i < 8192 * 16; i += gthreads) {
            const int t = i >> 4, ii = i & 15, m = ii & 7;
            const float inv = powf(10000.f, -(float)(2 * m) / 16.f);
            const float pos = (float)(ii < 8 ? (t >> 6) : (t & 63));
            const float ang = pos * inv;
            rc[i] = cosf(ang); rs[i] = sinf(ang);
        }
        float* tw = (float*)(ws + OFF_TW8192);
        for (int i = gtid; i < 8192; i += gthreads) { float s, c; sincospif(2.f * (float)i / 8192.f, &s, &c); tw[2 * i] = c; tw[2 * i + 1] = s; }
        float* tw2 = (float*)(ws + OFF_TW256);
        for (int i = gtid; i < 256; i += gthreads) { float s, c; sincospif(2.f * (float)i / 256.f, &s, &c); tw2[2 * i] = c; tw2[2 * i + 1] = s; }
        bf16_t* t0 = (bf16_t*)(ws + OFF_T0);
        for (int i = gtid; i < 128 * 64; i += gthreads) {
            const int c2 = i >> 6, j = i & 63, kp = c2 >> 1, ri = c2 & 1;
            float s, c; sincospif(2.f * (float)((j * kp) & 63) / 64.f, &s, &c);
            t0[i] = f2bf(ri == 0 ? c : -s);
        }
        gen_t1((bf16_t*)(ws + OFF_T1L), 128, gtid, gthreads);
        gen_t1((bf16_t*)(ws + OFF_T1C), 16, gtid, gthreads);
        gen_t2((bf16_t*)(ws + OFF_T2L), 64, gtid, gthreads);
        gen_t2((bf16_t*)(ws + OFF_T2C), 16, gtid, gthreads);
    }
    {
        float* abar = (float*)(ws + OFF_ABAR); float* a64 = (float*)(ws + OFF_A64); bf16_t* bbt = (bf16_t*)(ws + OFF_BBAR);
        for (int i = gtid; i < 2 * 24 * 64; i += gthreads) {
            const int n = i & 63, dg = i >> 6;
            const size_t pi = (size_t)l * 2 * 24 * 64 + i;
            const float are = p.in[13][pi], aim = p.in[14][pi];
            const float dt = expf(p.in[15][l * 48 + dg]);
            const float mag = expf(dt * are); float sn, cs; sincosf(dt * aim, &sn, &cs);
            const float br = mag * cs, bi = mag * sn;
            abar[2 * i] = br; abar[2 * i + 1] = bi;
            float pr = br, pim = bi;
#pragma unroll
            for (int k = 0; k < 6; ++k) { const float nr = pr * pr - pim * pim, ni = 2.f * pr * pim; pr = nr; pim = ni; }
            a64[2 * i] = pr; a64[2 * i + 1] = pim;
            const float nr = br - 1.f, ni = bi, den = are * are + aim * aim;
            const float cr = (nr * are + ni * aim) / den, ci = (ni * are - nr * aim) / den;
            const float* bre = p.in[16] + pi * 16; const float* bim = p.in[17] + pi * 16;
#pragma unroll
            for (int q = 0; q < 16; ++q) {
                const float xr = bre[q], xi = bim[q];
                bbt[((size_t)dg * 128 + 2 * n) * 16 + q] = f2bf(cr * xr - ci * xi);
                bbt[((size_t)dg * 128 + 2 * n + 1) * 16 + q] = f2bf(cr * xi + ci * xr);
            }
        }
        bf16_t* cxt = (bf16_t*)(ws + OFF_CXT);
        for (int i = gtid; i < 2 * 24 * 16 * 64; i += gthreads) {
            const size_t pi = (size_t)l * 2 * 24 * 16 * 64 + i;
            const int n = i & 63, dgp = i >> 6;
            cxt[(size_t)dgp * 128 + 2 * n] = f2bf(p.in[18][pi]);
            cxt[(size_t)dgp * 128 + 2 * n + 1] = f2bf(-p.in[19][pi]);
        }
    }
    bf16_t* W = (bf16_t*)(ws + OFF_W);
    conv_job(p.in[8] + (size_t)l * 1024 * 1440, 1024, 1440, 1440, 0, W + WO_IN, LD1, smem);
    conv_job(p.in[26] + (size_t)l * 1024 * 3072, 1024, 3072, 3072, 0, W + WO_GATE, LD1, smem);
    conv_job(p.in[10] + (size_t)l * 384 * 768, 384, 768, 768, 0, W + WO_UQ, 384, smem);
    conv_job(p.in[12] + (size_t)l * 256 * 1024, 256, 512, 1024, 1, W + WO_K, 256, smem);
    conv_job(p.in[12] + (size_t)l * 256 * 1024, 256, 512, 1024, 2, W + WO_V, 256, smem);
    conv_job(p.in[21] + (size_t)l * 384 * 384, 384, 384, 384, 0, W + WO_GLU, 384, smem);
    conv_job(p.in[23] + (size_t)l * 512 * 1024, 512, 1024, 1024, 0, W + WO_BA, 512, smem);
    conv_job(p.in[24] + (size_t)l * 384 * 1024, 384, 1024, 1024, 0, W + WO_BF, 384, smem);
    conv_job(p.in[25] + (size_t)l * 384 * 1024, 384, 1024, 1024, 0, W + WO_BS, 384, smem);
    conv_job(p.in[28] + (size_t)l * 1024 * 1024, 1024, 1024, 1024, 0, W + WO_OUT, LD1, smem);
    conv_job(p.in[29] + (size_t)l * 1024 * 4096, 1024, 4096, 4096, 0, W + WO_1, LD1, smem);
    conv_job(p.in[30] + (size_t)l * 4096 * 1024, 4096, 1024, 1024, 0, W + WO_2, LD4, smem);
}

DI void phase_norm(const Params& p, int l, int which) {
    const int lane = TID_ & 63, gw = BID_ * 4 + (TID_ >> 6), nw = GDIM_ * 4;
    const float* ln = p.in[which == 0 ? 6 : 7] + l * 1024;
    const bool orig = (which == 0 && l == 0);
    bf16_t* H = (bf16_t*)(p.ws + OFF_H);
    for (int row = gw; row < R; row += nw) {
        const float* x = xptr(p, orig, row);
        const float* mod = (const float*)(p.ws + OFF_MOD) + (size_t)(l * 3 + srow_of(row)) * 6144 + (which == 0 ? 0 : 3072);
        f32x4 v[4]; float ss = 0.f;
#pragma unroll
        for (int i = 0; i < 4; ++i) { v[i] = *(const f32x4*)(x + i * 256 + lane * 4); ss += v[i][0] * v[i][0] + v[i][1] * v[i][1] + v[i][2] * v[i][2] + v[i][3] * v[i][3]; }
        if (orig && (row % TPB) < CTX) {
            float* xc = xptr(p, false, row);
#pragma unroll
            for (int i = 0; i < 4; ++i) *(f32x4*)(xc + i * 256 + lane * 4) = v[i];
        }
        ss = wave_sum(ss);
        const float rstd = rsqrtf(ss * (1.f / 1024.f) + 1e-6f);
#pragma unroll
        for (int i = 0; i < 4; ++i) {
            const int c = i * 256 + lane * 4;
            const f32x4 g = *(const f32x4*)(ln + c), sh = *(const f32x4*)(mod + c), sc = *(const f32x4*)(mod + 1024 + c);
            float o[4];
#pragma unroll
            for (int j = 0; j < 4; ++j) o[j] = v[i][j] * rstd * g[j] * (1.f + sc[j]) + sh[j];
            st_bf4(H + (size_t)row * LD1 + c, o[0], o[1], o[2], o[3]);
        }
    }
}
DI void phase_final(const Params& p) {
    const int lane = TID_ & 63, gw = BID_ * 4 + (TID_ >> 6), nw = GDIM_ * 4;
    const float* fn = p.in[31];
    for (int r = gw; r < 2 * SEQ; r += nw) {
        float* x = p.out + (size_t)r * 1024;
        f32x4 v[4]; float ss = 0.f;
#pragma unroll
        for (int i = 0; i < 4; ++i) { v[i] = *(const f32x4*)(x + i * 256 + lane * 4); ss += v[i][0] * v[i][0] + v[i][1] * v[i][1] + v[i][2] * v[i][2] + v[i][3] * v[i][3]; }
        ss = wave_sum(ss);
        const float rstd = rsqrtf(ss * (1.f / 1024.f) + 1e-6f);
#pragma unroll
        for (int i = 0; i < 4; ++i) {
            const int c = i * 256 + lane * 4;
            const f32x4 g = *(const f32x4*)(fn + c);
            f32x4 o;
#pragma unroll
            for (int j = 0; j < 4; ++j) o[j] = v[i][j] * rstd * g[j];
            *(f32x4*)(x + c) = o;
        }
    }
}
DI void unpack8(u32x4 w, float (&v)[8]) { v[0] = bflo(w.x); v[1] = bfhi(w.x); v[2] = bflo(w.y); v[3] = bfhi(w.y); v[4] = bflo(w.z); v[5] = bfhi(w.z); v[6] = bflo(w.w); v[7] = bfhi(w.w); }
DI u32x4 pack8(const float (&v)[8]) { u32x4 w; w.x = pack2(v[0], v[1]); w.y = pack2(v[2], v[3]); w.z = pack2(v[4], v[5]); w.w = pack2(v[6], v[7]); return w; }
DI void phase_znorm(const Params& p, int l) {
    const int lane = TID_ & 63, gw = BID_ * 4 + (TID_ >> 6), nw = GDIM_ * 4;
    const bf16_t* Z = (const bf16_t*)(p.ws + OFF_Z);
    bf16_t* QIN = (bf16_t*)(p.ws + OFF_T + T_QIN); bf16_t* CKV = (bf16_t*)(p.ws + OFF_T + T_CKV); bf16_t* Kb = (bf16_t*)(p.ws + OFF_K);
    const float* qn = p.in[9] + l * 384; const float* kvn = p.in[11] + l * 256;
    const float* rc = (const float*)(p.ws + OFF_ROPE); const float* rs = rc + 8192 * 16;
    for (int row = gw; row < R; row += nw) {
        const bf16_t* z = Z + (size_t)row * 1440;
        float q[8], k[8], ssq = 0.f, ssk = 0.f;
        if (lane < 48) { unpack8(*(const u32x4*)(z + lane * 8), q);
#pragma unroll
            for (int j = 0; j < 8; ++j) ssq += q[j] * q[j]; }
        if (lane < 32) { unpack8(*(const u32x4*)(z + 384 + lane * 8), k);
#pragma unroll
            for (int j = 0; j < 8; ++j) ssk += k[j] * k[j]; }
        ssq = wave_sum(ssq); ssk = wave_sum(ssk);
        const float rq = rsqrtf(ssq * (1.f / 384.f) + 1e-6f), rk = rsqrtf(ssk * (1.f / 256.f) + 1e-6f);
        if (lane < 48) {
            const f32x4 g0 = *(const f32x4*)(qn + lane * 8), g1 = *(const f32x4*)(qn + lane * 8 + 4);
#pragma unroll
            for (int j = 0; j < 4; ++j) { q[j] *= rq * g0[j]; q[4 + j] *= rq * g1[j]; }
            *(u32x4*)(QIN + (size_t)row * 384 + lane * 8) = pack8(q);
        }
        if (lane < 32) {
            const f32x4 g0 = *(const f32x4*)(kvn + lane * 8), g1 = *(const f32x4*)(kvn + lane * 8 + 4);
#pragma unroll
            for (int j = 0; j < 4; ++j) { k[j] *= rk * g0[j]; k[4 + j] *= rk * g1[j]; }
            *(u32x4*)(CKV + (size_t)row * 256 + lane * 8) = pack8(k);
            const int h = lane >> 2, part = lane & 3, i0 = (part & 1) * 8, t = row % TPB;
            float x1[8], x2[8], o[8];
            unpack8(*(const u32x4*)(z + 640 + i0), x1); unpack8(*(const u32x4*)(z + 656 + i0), x2);
            if (t >= CTX) {
                const float* cp = rc + (size_t)(t - CTX) * 16 + i0; const float* sp = rs + (size_t)(t - CTX) * 16 + i0;
                const f32x4 c0 = *(const f32x4*)cp, c1 = *(const f32x4*)(cp + 4), s0 = *(const f32x4*)sp, s1 = *(const f32x4*)(sp + 4);
#pragma unroll
                for (int j = 0; j < 8; ++j) { const float c = j < 4 ? c0[j & 3] : c1[j & 3], s = j < 4 ? s0[j & 3] : s1[j & 3];
                    o[j] = part < 2 ? x1[j] * c - x2[j] * s : x2[j] * c + x1[j] * s; }
            } else {
#pragma unroll
                for (int j = 0; j < 8; ++j) o[j] = part < 2 ? x1[j] : x2[j];
            }
            *(u32x4*)(Kb + (size_t)row * 768 + h * 96 + 64 + part * 8) = pack8(o);
        }
    }
}

#define FOR_TILES(MT, NT, SN) \
    const int xcd_ = BID_ & 7, slot_ = BID_ >> 3, spx_ = GDIM_ >> 3, SM_ = 64 / (SN), nsn_ = (NT) / (SN), nst_ = (((MT) + SM_ - 1) / SM_) * nsn_; \
    for (int s_ = xcd_; s_ < nst_; s_ += 8) for (int sl_ = slot_; sl_ < 64; sl_ += spx_)
#define TILE_MT(SN) ((s_ / nsn_) * SM_ + sl_ / (SN))
#define TILE_NT(SN) ((s_ % nsn_) * (SN) + sl_ % (SN))
DI void phase_gemm_z(const Params& p, char* smem8) {
    const bf16_t* H = (const bf16_t*)(p.ws + OFF_H); const bf16_t* W = (const bf16_t*)(p.ws + OFF_W) + WO_IN; bf16_t* Z = (bf16_t*)(p.ws + OFF_Z);
    for (int tile = PBID_; tile < 66 * 6; tile += PGDIM_) {
        const int row0 = (tile / 6) * 256, col0 = (tile % 6) * 256;
        f32x4 acc[8][4];
        gemm_main3(acc, H, LD1, R, W, LD1, 1440, 1024, row0, col0, smem8);
        stage_tile8(acc, smem8, Z, 1440, row0, col0, 1440);
    }
}
DI void phase_gemm_qkv(const Params& p, char* smem) {
    const bf16_t* QIN = (const bf16_t*)(p.ws + OFF_T + T_QIN); const bf16_t* CKV = (const bf16_t*)(p.ws + OFF_T + T_CKV);
    const bf16_t* W = (const bf16_t*)(p.ws + OFF_W);
    bf16_t* Qb = (bf16_t*)(p.ws + OFF_Q); bf16_t* Kb = (bf16_t*)(p.ws + OFF_K); bf16_t* Vt = (bf16_t*)(p.ws + OFF_VT);
    const float* rc = (const float*)(p.ws + OFF_ROPE); const float* rs = rc + 8192 * 16;
    const float qscale = 0.10206207261596577f * 1.4426950408889634f;
    for (int tile = BID_; tile < 792 + 528 + 528; tile += GDIM_) {
        f32x4 acc[4][4];
        if (tile < 792) {
            const int row0 = (tile / 6) * 128, col0 = (tile % 6) * 128;
            gemm_main(acc, QIN, 384, R, W + WO_UQ, 384, 768, 384, row0, col0, smem);
            EPI_VARS
            const int gn0 = (col0 + wn_ * 64) >> 4;
#pragma unroll
            for (int mi = 0; mi < 4; ++mi) {
                const int row = EPI_ROW(mi), t = row % TPB;
#pragma unroll
                for (int ni = 0; ni < 3; ++ni) {
                    if ((gn0 + ni) % 6 == 4 && t >= CTX) {
                        const f32x4 c = *(const f32x4*)(rc + (size_t)(t - CTX) * 16 + quad_ * 4), s = *(const f32x4*)(rs + (size_t)(t - CTX) * 16 + quad_ * 4);
                        const f32x4 x1 = acc[mi][ni], x2 = acc[mi][ni + 1];
                        acc[mi][ni] = x1 * c - x2 * s; acc[mi][ni + 1] = x2 * c + x1 * s;
                    }
                }
#pragma unroll
                for (int ni = 0; ni < 4; ++ni) acc[mi][ni] *= qscale;
            }
            stage_tile_bf16<4>(acc, smem, Qb, 768, row0, col0, 768);
        } else if (tile < 792 + 528) {
            const int tt = tile - 792, row0 = (tt / 4) * 128, col0 = (tt % 4) * 128;
            gemm_main(acc, CKV, 256, R, W + WO_K, 256, 512, 256, row0, col0, smem);
            EPI_VARS
            stage_tile_bf16<4>(acc, smem, Kb, 768, row0, col0, 512, true);
        } else {
            const int tt = tile - 792 - 528, row0 = (tt & 3) * 128, col0 = (tt >> 2) * 128;
            gemm_main(acc, W + WO_V, 256, 512, CKV, 256, R, 256, row0, col0, smem);
            EPI_VARS
            { const int b_ = col0 / TPB, t0_ = col0 - b_ * TPB;
              stage_tile_bf16<4>(acc, smem, Vt + (size_t)(b_ * 512) * TPB + t0_, TPB, row0, 0, 128); }
        }
    }
}
DI void phase_gemm_glu(const Params& p, int l, char* smem) {
    const bf16_t* YG = (const bf16_t*)(p.ws + OFF_T + T_YG); const bf16_t* W = (const bf16_t*)(p.ws + OFF_W) + WO_GLU; bf16_t* OS = (bf16_t*)(p.ws + OFF_OS);
    const float* bg = p.in[22] + l * 384;
    for (int tile = BID_; tile < 132 * 3; tile += GDIM_) {
        const int row0 = (tile / 3) * 128, col0 = (tile % 3) * 128;
        f32x4 acc[4][4];
        gemm_main(acc, YG, 384, R, W, 384, 384, 384, row0, col0, smem);
        EPI_VARS
#pragma unroll
        for (int mi = 0; mi < 4; ++mi)
#pragma unroll
            for (int ni = 0; ni < 4; ++ni) {
                const int row = EPI_ROW(mi), col = EPI_COL(ni);
                const uint2 yw = *(const uint2*)(YG + (size_t)row * 384 + col);
                const f32x4 b = *(const f32x4*)(bg + col);
                const float y0 = bflo(yw.x), y1 = bfhi(yw.x), y2 = bflo(yw.y), y3 = bfhi(yw.y);
                st_bf4(OS + (size_t)row * 384 + col, y0 * sigmoidf_(acc[mi][ni][0] + b[0]), y1 * sigmoidf_(acc[mi][ni][1] + b[1]),
                       y2 * sigmoidf_(acc[mi][ni][2] + b[2]), y3 * sigmoidf_(acc[mi][ni][3] + b[3]));
            }
    }
}
DI void phase_merge(const Params& p, int l, char* smem, char* smem8) {
    const bf16_t* H = (const bf16_t*)(p.ws + OFF_H); const bf16_t* W = (const bf16_t*)(p.ws + OFF_W);
    const bf16_t* OA = (const bf16_t*)(p.ws + OFF_OA); const bf16_t* OFb = (const bf16_t*)(p.ws + OFF_OF); const bf16_t* OS = (const bf16_t*)(p.ws + OFF_OS);
    bf16_t* M = (bf16_t*)(p.ws + OFF_Z);
    const float* bgate = p.in[27] + l * 3072;
    for (int tile = PBID_; tile < 256; tile += PGDIM_) {
        const int rt = tile >> 2, row0 = ((rt >> 5) * 33 + 1 + (rt & 31)) * 256, col0 = (tile & 3) * 256;
#pragma unroll 1
        for (int br = 0; br < 3; ++br) {
            f32x4 acc[8][4];
            gemm_main3(acc, H, LD1, R, W + WO_GATE + (size_t)br * 1024 * LD1, LD1, 1024, 1024, row0, col0, smem8);
            {
                EPI8_VARS
                unsigned* gs = (unsigned*)(p.ws + OFF_Q) + ((size_t)tile * 2 * 64 * 512) + tid8_;
                const float* bg = bgate + br * 1024 + col0 + wc_ * 64 + quade_ * 4;
#pragma unroll
                for (int mi = 0; mi < 8; ++mi) {
                    __builtin_amdgcn_sched_barrier(0);
#pragma unroll
                    for (int ni = 0; ni < 4; ++ni) {
                        const f32x4 bb = *(const f32x4*)(bg + ni * 16);
                        gs[((mi * 4 + ni) * 2 + 0) * 512] = pack2(sigmoidf_(acc[mi][ni][0] + bb[0]), sigmoidf_(acc[mi][ni][1] + bb[1]));
                        gs[((mi * 4 + ni) * 2 + 1) * 512] = pack2(sigmoidf_(acc[mi][ni][2] + bb[2]), sigmoidf_(acc[mi][ni][3] + bb[3]));
                    }
                }
            }
            const bf16_t* Ab = br == 0 ? OA : (br == 1 ? OFb : OS);
            const int Kb = br == 0 ? 512 : 384;
            const bf16_t* Wb = W + (br == 0 ? WO_BA : (br == 1 ? WO_BF : WO_BS));
            gemm_main3(acc, Ab, Kb, R, Wb, Kb, 1024, Kb, row0, col0, smem8);
            {
                EPI8_VARS
                unsigned* gs = (unsigned*)(p.ws + OFF_Q) + ((size_t)tile * 2 * 64 * 512) + tid8_;
                unsigned* ts = gs + 64 * 512;
#pragma unroll
                for (int mi = 0; mi < 8; ++mi) {
                    __builtin_amdgcn_sched_barrier(0);
#pragma unroll
                    for (int ni = 0; ni < 4; ++ni) {
                        const unsigned g0 = gs[((mi * 4 + ni) * 2 + 0) * 512], g1 = gs[((mi * 4 + ni) * 2 + 1) * 512];
                        f32x4 t = {0.f, 0.f, 0.f, 0.f};
                        if (br > 0) { const unsigned t0 = ts[((mi * 4 + ni) * 2 + 0) * 512], t1 = ts[((mi * 4 + ni) * 2 + 1) * 512]; t = (f32x4){bflo(t0), bfhi(t0), bflo(t1), bfhi(t1)}; }
                        t[0] += bflo(g0) * acc[mi][ni][0]; t[1] += bfhi(g0) * acc[mi][ni][1]; t[2] += bflo(g1) * acc[mi][ni][2]; t[3] += bfhi(g1) * acc[mi][ni][3];
                        if (br < 2) { ts[((mi * 4 + ni) * 2 + 0) * 512] = pack2(t[0], t[1]); ts[((mi * 4 + ni) * 2 + 1) * 512] = pack2(t[2], t[3]); }
                        acc[mi][ni] = t;
                    }
                }
            }
            if (br == 2) stage_tile8(acc, smem8, M, LD1, row0, col0, 1024);
        }
    }
    const int nctx = (l == 0 ? 32 : 0);
    for (int tile = BID_; tile < nctx; tile += GDIM_) {
        const int ct = tile >> 3, row0 = (ct >> 1) * TPB + (ct & 1) * 128, col0 = (tile & 7) * 128;
        const size_t sbase = (size_t)256 * 2 * 64 * 512 + (size_t)tile * 32 * 256;
#pragma unroll 1
        for (int br = 0; br < 3; ++br) {
            {
                f32x4 acc[4][4];
                gemm_main(acc, H, LD1, R, W + WO_GATE + (size_t)br * 1024 * LD1, LD1, 1024, 1024, row0, col0, smem);
                EPI_VARS
                unsigned* gs = (unsigned*)(p.ws + OFF_Q) + sbase + tid_;
#pragma unroll
                for (int mi = 0; mi < 4; ++mi)
#pragma unroll
                    for (int ni = 0; ni < 4; ++ni) {
                        const f32x4 b = *(const f32x4*)(bgate + br * 1024 + EPI_COL(ni));
                        gs[((mi * 4 + ni) * 2 + 0) * 256] = pack2(sigmoidf_(acc[mi][ni][0] + b[0]), sigmoidf_(acc[mi][ni][1] + b[1]));
                        gs[((mi * 4 + ni) * 2 + 1) * 256] = pack2(sigmoidf_(acc[mi][ni][2] + b[2]), sigmoidf_(acc[mi][ni][3] + b[3]));
                    }
            }
            f32x4 acc[4][4];
            const bf16_t* Ab = br == 0 ? OA : (br == 1 ? OFb : OS);
            const int Kb = br == 0 ? 512 : 384;
            const bf16_t* Wb = W + (br == 0 ? WO_BA : (br == 1 ? WO_BF : WO_BS));
            gemm_main(acc, Ab, Kb, R, Wb, Kb, 1024, Kb, row0, col0, smem);
            EPI_VARS
            const unsigned* gs = (const unsigned*)(p.ws + OFF_Q) + sbase + tid_;
#pragma unroll
            for (int mi = 0; mi < 4; ++mi)
#pragma unroll
                for (int ni = 0; ni < 4; ++ni) {
                    const unsigned g0 = gs[((mi * 4 + ni) * 2 + 0) * 256], g1 = gs[((mi * 4 + ni) * 2 + 1) * 256];
                    uint2* mp = (uint2*)(M + (size_t)EPI_ROW(mi) * LD1 + EPI_COL(ni));
                    uint2 t = make_uint2(0u, 0u);
                    if (br > 0) t = *mp;
                    t.x = pack2(bflo(t.x) + bflo(g0) * acc[mi][ni][0], bfhi(t.x) + bfhi(g0) * acc[mi][ni][1]);
                    t.y = pack2(bflo(t.y) + bflo(g1) * acc[mi][ni][2], bfhi(t.y) + bfhi(g1) * acc[mi][ni][3]);
                    *mp = t;
                }
        }
    }
}
DI void phase_gemm_res(const Params& p, int l, int which, char* smem, char* smem8) {
    const bf16_t* A = (const bf16_t*)(p.ws + OFF_Z); const bf16_t* W = (const bf16_t*)(p.ws + OFF_W) + (which == 0 ? WO_OUT : WO_2);
    const int K = which == 0 ? 1024 : 4096, LDK = which == 0 ? LD1 : LD4;
    const bool orig = (which == 0 && l == 0);
    const int goff = which == 0 ? 2048 : 5120;
    {
        for (int tile = PBID_; tile < 256; tile += PGDIM_) {
            const int rt = tile >> 2, row0 = ((rt >> 5) * 33 + 1 + (rt & 31)) * 256, col0 = (tile & 3) * 256;
            f32x4 acc[8][4];
            gemm_main3(acc, A, LDK, R, W, LDK, 1024, K, row0, col0, smem8);
            EPI8_VARS
            const int b_ = rt >> 5;
            const size_t lat0 = (size_t)(b_ * SEQ + (rt & 31) * 256) * 1024;
            const float* xin = (orig ? p.in[0] : p.out) + lat0; float* xout = p.out + lat0;
            const float* gate = (const float*)(p.ws + OFF_MOD) + (size_t)(l * 3 + b_) * 6144 + goff;
#pragma unroll
            for (int mi = 0; mi < 8; ++mi) {
                __builtin_amdgcn_sched_barrier(0);
                const size_t ro = (size_t)(wr_ * 128 + mi * 16 + l15e_) * 1024;
#pragma unroll
                for (int ni = 0; ni < 4; ++ni) {
                    const int col = EPI8_COL(ni);
                    const f32x4 x = *(const f32x4*)(xin + ro + col), g = *(const f32x4*)(gate + col);
                    *(f32x4*)(xout + ro + col) = x + g * acc[mi][ni];
                }
            }
        }
    }
    const int ksh = which == 0 ? 2 : 3, KS = 1 << ksh, Kc = K >> ksh;
    const int nitems = (l == 0 ? 32 << ksh : 0);
    for (int item = BID_; item < nitems; item += GDIM_) {
        const int tt = item >> ksh, kp = item & (KS - 1), ct = tt >> 3, row0 = (ct >> 1) * TPB + (ct & 1) * 128, col0 = (tt & 7) * 128;
        f32x4 acc[4][4];
        gemm_main(acc, A + kp * Kc, LDK, R, W + kp * Kc, LDK, 1024, Kc, row0, col0, smem);
        EPI_VARS
        float* xcb = (float*)(p.ws + OFF_XC) + (size_t)((ct >> 1) * CTX + (ct & 1) * 128) * 1024;
        const float* gate = (const float*)(p.ws + OFF_MOD) + (size_t)(l * 3 + 2) * 6144 + goff;
#pragma unroll
        for (int mi = 0; mi < 4; ++mi) {
            __builtin_amdgcn_sched_barrier(0);
            float* xo = xcb + (size_t)(wm_ * 64 + mi * 16 + l15_) * 1024;
#pragma unroll
            for (int ni = 0; ni < 4; ++ni) {
                const int col = EPI_COL(ni);
                const f32x4 g = *(const f32x4*)(gate + col);
#pragma unroll
                for (int j = 0; j < 4; ++j) unsafeAtomicAdd(xo + col + j, g[j] * acc[mi][ni][j]);
            }
        }
    }
}
DI void phase_mlp1(const Params& p, int l, char* smem, char* smem8) {
    const bf16_t* H = (const bf16_t*)(p.ws + OFF_H); const bf16_t* W = (const bf16_t*)(p.ws + OFF_W) + WO_1; bf16_t* U = (bf16_t*)(p.ws + OFF_Z);
    for (int tile = PBID_; tile < 1024; tile += PGDIM_) {
        const int rt = tile >> 4, row0 = ((rt >> 5) * 33 + 1 + (rt & 31)) * 256, col0 = (tile & 15) * 256;
        f32x4 acc[8][4];
        gemm_main3(acc, H, LD1, R, W, LD1, 4096, 1024, row0, col0, smem8);
#pragma unroll
        for (int mi = 0; mi < 8; ++mi)
#pragma unroll
            for (int ni = 0; ni < 4; ++ni)
#pragma unroll
                for (int j = 0; j < 4; ++j) { const float r = fmaxf(acc[mi][ni][j], 0.f); acc[mi][ni][j] = r * r; }
        stage_tile8(acc, smem8, U, LD4, row0, col0, 4096);
    }
    const int ntiles = (l == 0 ? 128 : 0);
    for (int tile = BID_; tile < ntiles; tile += GDIM_) {
        const int ct = tile >> 5, row0 = (ct >> 1) * TPB + (ct & 1) * 128, col0 = (tile & 31) * 128;
        f32x4 acc[4][4];
        gemm_main(acc, H, LD1, R, W, LD1, 4096, 1024, row0, col0, smem);
#pragma unroll
        for (int mi = 0; mi < 4; ++mi)
#pragma unroll
            for (int ni = 0; ni < 4; ++ni)
#pragma unroll
                for (int j = 0; j < 4; ++j) { const float r = fmaxf(acc[mi][ni][j], 0.f); acc[mi][ni][j] = r * r; }
        stage_tile_bf16<4>(acc, smem, U, LD4, row0, col0, 4096);
    }
}

DI void attn_item(const Params& p, int b, int h, int qrow0, int nkeys, char* smem) {
    const int tid = TID_, lane = tid & 63, wave = tid >> 6, l15 = lane & 15, quad = lane >> 4;
    const bf16_t* Qb = (const bf16_t*)(p.ws + OFF_Q); const bf16_t* Kb = (const bf16_t*)(p.ws + OFF_K); const bf16_t* Vt = (const bf16_t*)(p.ws + OFF_VT);
    bf16_t* OA = (bf16_t*)(p.ws + OFF_OA);
    char* Ks = smem;
    bf16_t* Vs = (bf16_t*)(smem + 2 * 12288);
    bf16x8 qf[4][3];
#pragma unroll
    for (int qt = 0; qt < 4; ++qt)
#pragma unroll
        for (int s = 0; s < 3; ++s) qf[qt][s] = *(const bf16x8*)(Qb + (size_t)(qrow0 + wave * 64 + qt * 16 + l15) * 768 + h * 96 + s * 32 + quad * 8);
    f32x4 o[4][4];
#pragma unroll
    for (int i = 0; i < 4; ++i)
#pragma unroll
        for (int j = 0; j < 4; ++j) o[i][j] = (f32x4){0.f, 0.f, 0.f, 0.f};
    float m[4] = {0.f, 0.f, 0.f, 0.f}, lsum[4] = {0.f, 0.f, 0.f, 0.f};
    bool first = true;
    int kp[3], vp[2];
    const bf16_t* kbase = Kb + ((size_t)b * TPB) * 768 + h * 96; const bf16_t* vbase = Vt + (size_t)(b * 8 + h) * 64 * TPB;
    const int sb_ = lane * 16, swz_ = sb_ ^ (((sb_ >> 9) & 1) << 5), sr_ = swz_ >> 6, sk_ = (swz_ & 63) >> 1;
    const int lo = (l15 * 64 + quad * 16) ^ ((l15 >> 3) << 5);
#pragma unroll
    for (int i = 0; i < 3; ++i) { const int st = wave + 4 * i, key = (st / 3) * 16 + sr_, dim = (st % 3) * 32 + sk_; kp[i] = key * 768 + dim; }
#pragma unroll
    for (int i = 0; i < 2; ++i) { const int d = (wave * 2 + i) * 8 + (lane >> 3), c = (lane & 7) ^ ((d >> 1) & 7); vp[i] = d * TPB + c * 8; }
    const int kofs = wave * 1024 + lane * 16;
    const int vofs = wave * 2048 + lane * 16;
    u32x4 kr[3], vr[2];
#pragma unroll
    for (int i = 0; i < 3; ++i) kr[i] = *(const u32x4*)(kbase + kp[i]);
#pragma unroll
    for (int i = 0; i < 2; ++i) vr[i] = *(const u32x4*)(vbase + vp[i]);
#pragma unroll
    for (int i = 0; i < 3; ++i) *(u32x4*)(Ks + i * 4096 + kofs) = kr[i];
#pragma unroll
    for (int i = 0; i < 2; ++i) *(u32x4*)((char*)Vs + i * 1024 + vofs) = vr[i];
    __syncthreads();
    const int NT = nkeys >> 6;
    for (int it = 0; it < NT; ++it) {
        const int buf = it & 1;
        if (it + 1 < NT) {
#pragma unroll
            for (int i = 0; i < 3; ++i) kr[i] = *(const u32x4*)(kbase + (size_t)(it + 1) * 64 * 768 + kp[i]);
#pragma unroll
            for (int i = 0; i < 2; ++i) vr[i] = *(const u32x4*)(vbase + (it + 1) * 64 + vp[i]);
        }
#pragma unroll
        for (int hk = 0; hk < 2; ++hk) {
            f32x4 s[2][4];
#pragma unroll
            for (int k2 = 0; k2 < 2; ++k2) {
#pragma unroll
                for (int qt = 0; qt < 4; ++qt) { const float nm = -m[qt]; s[k2][qt] = (f32x4){nm, nm, nm, nm}; }
#pragma unroll
                for (int ss = 0; ss < 3; ++ss) {
                    const bf16x8 kf = *(const bf16x8*)(Ks + buf * 12288 + ((hk * 2 + k2) * 3 + ss) * 1024 + lo);
#pragma unroll
                    for (int qt = 0; qt < 4; ++qt) s[k2][qt] = MFMA16(kf, qf[qt][ss], s[k2][qt]);
                }
            }
            bf16x8 pf[4];
#pragma unroll
            for (int qt = 0; qt < 4; ++qt) {
                float mx = max3f(s[0][qt][0], s[0][qt][1], s[0][qt][2]);
                mx = max3f(mx, s[0][qt][3], s[1][qt][0]);
                mx = max3f(mx, s[1][qt][1], s[1][qt][2]);
                mx = fmaxf(mx, s[1][qt][3]);
                if (__builtin_amdgcn_ballot_w64(mx > 8.f || first) != 0) {
                    mx = fmaxf(mx, shx(mx, 16)); mx = fmaxf(mx, shx(mx, 32));
                    const float d = first ? mx : fmaxf(mx, 0.f);
                    const float alpha = __builtin_amdgcn_exp2f(-d);
                    m[qt] += d; lsum[qt] *= alpha;
#pragma unroll
                    for (int dt = 0; dt < 4; ++dt) o[dt][qt] *= alpha;
#pragma unroll
                    for (int k2 = 0; k2 < 2; ++k2)
#pragma unroll
                        for (int j = 0; j < 4; ++j) s[k2][qt][j] -= d;
                }
                float rsum = 0.f;
#pragma unroll
                for (int k2 = 0; k2 < 2; ++k2)
#pragma unroll
                    for (int j = 0; j < 4; ++j) { const float pv = __builtin_amdgcn_exp2f(s[k2][qt][j]); s[k2][qt][j] = pv; rsum += pv; }
                lsum[qt] += rsum;
                u32x4 w;
                w.x = pack2(s[0][qt][0], s[0][qt][1]); w.y = pack2(s[0][qt][2], s[0][qt][3]);
                w.z = pack2(s[1][qt][0], s[1][qt][1]); w.w = pack2(s[1][qt][2], s[1][qt][3]);
                pf[qt] = __builtin_bit_cast(bf16x8, w);
            }
            first = false;
#pragma unroll
            for (int dt = 0; dt < 4; ++dt) {
                const int d_ = dt * 16 + l15, sw_ = (d_ >> 1) & 7, c0_ = hk * 4 + (quad >> 1);
                const char* vb_ = (const char*)Vs + buf * 8192 + d_ * 128 + (quad & 1) * 8;
                const uint2 lo2 = *(const uint2*)(vb_ + ((c0_ ^ sw_) << 4)), hi2 = *(const uint2*)(vb_ + (((c0_ + 2) ^ sw_) << 4));
                u32x4 w; w.x = lo2.x; w.y = lo2.y; w.z = hi2.x; w.w = hi2.y;
                const bf16x8 vf = __builtin_bit_cast(bf16x8, w);
#pragma unroll
                for (int qt = 0; qt < 4; ++qt) o[dt][qt] = MFMA16(vf, pf[qt], o[dt][qt]);
            }
        }
        if (it + 1 < NT) {
#pragma unroll
            for (int i = 0; i < 3; ++i) *(u32x4*)(Ks + (buf ^ 1) * 12288 + i * 4096 + kofs) = kr[i];
#pragma unroll
            for (int i = 0; i < 2; ++i) *(u32x4*)((char*)Vs + (buf ^ 1) * 8192 + i * 1024 + vofs) = vr[i];
        }
        __syncthreads();
    }
#pragma unroll
    for (int qt = 0; qt < 4; ++qt) {
        float ls = lsum[qt]; ls += shx(ls, 16); ls += shx(ls, 32);
        const float inv = 1.f / ls;
        const int row = qrow0 + wave * 64 + qt * 16 + l15;
#pragma unroll
        for (int dt = 0; dt < 4; ++dt)
            st_bf4(OA + (size_t)row * 512 + h * 64 + dt * 16 + quad * 4, o[dt][qt][0] * inv, o[dt][qt][1] * inv, o[dt][qt][2] * inv, o[dt][qt][3] * inv);
    }
}
DI void phase_attn(const Params& p, int l, char* smem) {
    if (PGDIM_ == 256) {
        const int pb = PBID_, x = pb & 7, local = (pb >> 3) * 2 + HALF_;
        const int pr = x + 8 * (local >> 5), qb = local & 31, b = pr >> 3, h = pr & 7;
        attn_item(p, b, h, b * TPB + CTX + qb * 256, TPB, smem);
    } else {
        for (int item = BID_; item < 512; item += GDIM_) { const int qb = item & 31, h = (item >> 5) & 7, b = item >> 8; attn_item(p, b, h, b * TPB + CTX + qb * 256, TPB, smem); }
    }
    if (l == 0)
        for (int it = BID_; it < 16; it += GDIM_) { const int h = it & 7, b = it >> 3; attn_item(p, b, h, b * TPB, CTX, smem); }
}

template <int N1, int N2>
DI void four1_item(const Params& p, int b, int n2, int g, int tok0, const bf16_t* __restrict__ T1, const float* __restrict__ TW, bf16_t* __restrict__ F1, char* smem) {
    const int tid = TID_, lane = tid & 63, wave = tid >> 6, l15 = lane & 15, quad = lane >> 4;
    constexpr int XS = 2 * N1 + 8;
    const bf16_t* Z = (const bf16_t*)(p.ws + OFF_Z); const bf16_t* T0 = (const bf16_t*)(p.ws + OFF_T0);
    bf16_t* Ua = (bf16_t*)smem;
    bf16_t* Xt = Ua + N1 * 72;
    for (int c = tid; c < N1 * 8; c += 256) {
        const int n1 = c >> 3, part = c & 7;
        *(uint4*)&Ua[n1 * 72 + part * 8] = *(const uint4*)(Z + (size_t)(tok0 + N2 * n1 + n2) * 1440 + 672 + g * 64 + part * 8);
    }
    __syncthreads();
    for (int mt = wave; mt < 8; mt += 4) {
        const bf16x8 a0 = *(const bf16x8*)(T0 + (mt * 16 + l15) * 64 + quad * 8);
        const bf16x8 a1 = *(const bf16x8*)(T0 + (mt * 16 + l15) * 64 + 32 + quad * 8);
#pragma unroll
        for (int nt = 0; nt < N1 / 16; ++nt) {
            f32x4 acc = {0.f, 0.f, 0.f, 0.f};
            acc = MFMA16(a0, *(const bf16x8*)&Ua[(nt * 16 + l15) * 72 + quad * 8], acc);
            acc = MFMA16(a1, *(const bf16x8*)&Ua[(nt * 16 + l15) * 72 + 32 + quad * 8], acc);
            const int kp0 = mt * 8 + quad * 2, n1 = nt * 16 + l15;
            *(unsigned*)&Xt[kp0 * XS + 2 * n1] = pack2(acc[0], acc[1]);
            *(unsigned*)&Xt[(kp0 + 1) * XS + 2 * n1] = pack2(acc[2], acc[3]);
        }
    }
    __syncthreads();
    for (int mt = wave; mt < 2 * N1 / 16; mt += 4) {
        constexpr int KS1 = 2 * N1 / 32;
        bf16x8 af[KS1];
#pragma unroll
        for (int ks = 0; ks < KS1; ++ks) af[ks] = *(const bf16x8*)(T1 + (mt * 16 + l15) * (2 * N1) + ks * 32 + quad * 8);
#pragma unroll
        for (int nt = 0; nt < 4; ++nt) {
            f32x4 acc = {0.f, 0.f, 0.f, 0.f};
#pragma unroll
            for (int ks = 0; ks < KS1; ++ks) {
                const bf16x8 bb = *(const bf16x8*)&Xt[(nt * 16 + l15) * XS + ks * 32 + quad * 8];
                acc = MFMA16(af[ks], bb, acc);
            }
            const int k1a = mt * 8 + quad * 2, kp = nt * 16 + l15;
#pragma unroll
            for (int hf = 0; hf < 2; ++hf) {
                const int k1 = k1a + hf; const float orr = acc[2 * hf], oi = acc[2 * hf + 1];
                const float c = TW[2 * (n2 * k1)], s = TW[2 * (n2 * k1) + 1];
                *(unsigned*)&F1[(((size_t)b * N1 + k1) * N2 + n2) * 768 + (g * 64 + kp) * 2] = pack2(orr * c + oi * s, oi * c - orr * s);
            }
        }
    }
    __syncthreads();
}
template <int N1, int N2>
DI void four2_item(const Params& p, int b, int k1, int g, int tok0, const bf16_t* __restrict__ T2, const bf16_t* __restrict__ F1, char* smem) {
    const int tid = TID_, lane = tid & 63, wave = tid >> 6, l15 = lane & 15, quad = lane >> 4;
    constexpr int DS = 2 * N2 + 8;
    bf16_t* OFb = (bf16_t*)(p.ws + OFF_OF);
    bf16_t* Dt = (bf16_t*)smem;
    for (int c = tid; c < N2 * 16; c += 256) {
        const int n2 = c >> 4, part = c & 15;
        const uint4 v = *(const uint4*)(F1 + (((size_t)b * N1 + k1) * N2 + n2) * 768 + g * 128 + part * 8);
        *(unsigned*)&Dt[(part * 4 + 0) * DS + 2 * n2] = v.x; *(unsigned*)&Dt[(part * 4 + 1) * DS + 2 * n2] = v.y;
        *(unsigned*)&Dt[(part * 4 + 2) * DS + 2 * n2] = v.z; *(unsigned*)&Dt[(part * 4 + 3) * DS + 2 * n2] = v.w;
    }
    __syncthreads();
    constexpr float scale = (N1 * N2 == 8192) ? 0.0013810679320049757f : 0.0078125f;
    {
        constexpr int NTT = N2 / 16, KS2 = 2 * N2 / 32;
        const int nt = NTT == 4 ? wave : 0;
        bf16x8 bt[KS2];
#pragma unroll
        for (int ks = 0; ks < KS2; ++ks) bt[ks] = *(const bf16x8*)(T2 + (nt * 16 + l15) * (2 * N2) + ks * 32 + quad * 8);
#pragma unroll
        for (int mi = 0; mi < (NTT == 4 ? 4 : 1); ++mi) {
            const int mt = NTT == 4 ? mi : wave;
            f32x4 acc = {0.f, 0.f, 0.f, 0.f};
#pragma unroll
            for (int ks = 0; ks < KS2; ++ks) {
                const bf16x8 a = *(const bf16x8*)&Dt[(mt * 16 + l15) * DS + ks * 32 + quad * 8];
                acc = MFMA16(a, bt[ks], acc);
            }
            const int k2 = nt * 16 + l15, row = tok0 + k1 + N1 * k2;
            st_bf4(OFb + (size_t)row * 384 + g * 64 + mt * 16 + quad * 4, acc[0] * scale, acc[1] * scale, acc[2] * scale, acc[3] * scale);
        }
    }
    __syncthreads();
}
DI void phase_four1(const Params& p, int l, char* smem) {
    const int nitems = 768 + (l == 0 ? 192 : 0);
    bf16_t* F1L = (bf16_t*)(p.ws + OFF_T + T_F1L); bf16_t* F1C = (bf16_t*)(p.ws + OFF_T + T_F1C);
    for (int item = BID_; item < nitems; item += GDIM_) {
        if (item < 768) { const int g = item % 6, n2 = (item / 6) & 63, b = item / 384;
            four1_item<128, 64>(p, b, n2, g, b * TPB + CTX, (const bf16_t*)(p.ws + OFF_T1L), (const float*)(p.ws + OFF_TW8192), F1L, smem); }
        else { const int it = item - 768, g = it % 6, n2 = (it / 6) & 15, b = it / 96;
            four1_item<16, 16>(p, b, n2, g, b * TPB, (const bf16_t*)(p.ws + OFF_T1C), (const float*)(p.ws + OFF_TW256), F1C, smem); }
    }
}
DI void phase_four2(const Params& p, int l, char* smem) {
    const int nitems = 1536 + (l == 0 ? 192 : 0);
    const bf16_t* F1L = (const bf16_t*)(p.ws + OFF_T + T_F1L); const bf16_t* F1C = (const bf16_t*)(p.ws + OFF_T + T_F1C);
    for (int item = BID_; item < nitems; item += GDIM_) {
        if (item < 1536) { const int g = item % 6, k1 = (item / 6) & 127, b = item / 768;
            four2_item<128, 64>(p, b, k1, g, b * TPB + CTX, (const bf16_t*)(p.ws + OFF_T2L), F1L, smem); }
        else { const int it = item - 1536, g = it % 6, k1 = (it / 6) & 15, b = it / 96;
            four2_item<16, 16>(p, b, k1, g, b * TPB, (const bf16_t*)(p.ws + OFF_T2C), F1C, smem); }
    }
}

#define WAVE_SYNC { __builtin_amdgcn_fence(__ATOMIC_RELEASE, "wavefront"); __builtin_amdgcn_wave_barrier(); __builtin_amdgcn_fence(__ATOMIC_ACQUIRE, "wavefront"); }
DI int ssm_tok(int dir, int sidx) { return dir == 0 ? sidx : (sidx < CTX ? CTX - 1 - sidx : (TPB + CTX - 1) - sidx); }
DI void ssm_load_bbf(const Params& p, int dg, int lane, bf16x8 (&bbf)[8]) {
    const bf16_t* bbt = (const bf16_t*)(p.ws + OFF_BBAR) + (size_t)dg * 128 * 16;
    const int l15 = lane & 15, quad = lane >> 4;
#pragma unroll
    for (int mt = 0; mt < 8; ++mt) {
        bf16x8 v = {0, 0, 0, 0, 0, 0, 0, 0};
        if (quad < 2) v = *(const bf16x8*)(bbt + (mt * 16 + l15) * 16 + quad * 8);
        bbf[mt] = v;
    }
}
template <bool REV, bool STORE>
DI void ssm_sub(const bf16_t* __restrict__ Z, int row0, int g, const bf16x8 (&bbf)[8], float ar, float ai, float& sr, float& si, float* BUs, unsigned* Sw, int lane) {
    const int l15 = lane & 15, quad = lane >> 4;
    bf16x8 uf = {0, 0, 0, 0, 0, 0, 0, 0};
    if (quad < 2) uf = *(const bf16x8*)(Z + (size_t)(row0 + l15) * 1440 + 1056 + g * 16 + quad * 8);
#pragma unroll
    for (int mt = 0; mt < 8; ++mt) {
        const f32x4 d = MFMA16(bbf[mt], uf, ((f32x4){0.f, 0.f, 0.f, 0.f}));
        *(f32x4*)&BUs[l15 * 132 + mt * 16 + quad * 4] = d;
    }
    WAVE_SYNC
#pragma unroll
    for (int i = 0; i < 16; ++i) {
        const int tt = REV ? 15 - i : i;
        const f2_t bq = *(const f2_t*)&BUs[tt * 132 + 2 * lane];
        const float nr = ar * sr - ai * si + bq[0], ni = ar * si + ai * sr + bq[1];
        sr = nr; si = ni;
        if (STORE) Sw[tt * 68 + lane] = pack2(sr, si);
    }
    WAVE_SYNC
}
DI void phase_ssm1(const Params& p, char* smem) {
    const int lane = TID_ & 63, wave = TID_ >> 6, gw = BID_ * 4 + wave, nw = GDIM_ * 4;
    const bf16_t* Z = (const bf16_t*)(p.ws + OFF_Z); float* SEND = (float*)(p.ws + OFF_OS + T_SEND);
    float* BUs = (float*)smem + wave * (16 * 132);
    for (int item = gw; item < 2 * 2 * 24 * 132; item += nw) {
        const int g = item % 24, q = (item / 24) % 132, dir = (item / (24 * 132)) & 1, b = item / (24 * 132 * 2);
        bf16x8 bbf[8]; ssm_load_bbf(p, dir * 24 + g, lane, bbf);
        const float* abar = (const float*)(p.ws + OFF_ABAR) + (size_t)((dir * 24 + g) * 64 + lane) * 2;
        const float ar = abar[0], ai = abar[1];
        float sr = 0.f, si = 0.f;
        for (int sb = 0; sb < 4; ++sb) {
            if (dir == 0) ssm_sub<false, false>(Z, b * TPB + q * 64 + sb * 16, g, bbf, ar, ai, sr, si, BUs, nullptr, lane);
            else ssm_sub<true, false>(Z, b * TPB + ssm_tok(1, q * 64 + sb * 16 + 15), g, bbf, ar, ai, sr, si, BUs, nullptr, lane);
        }
        float* dst = SEND + ((size_t)(((b * 2 + dir) * 24 + g) * 132 + q) * 64 + lane) * 2;
        dst[0] = sr; dst[1] = si;
    }
}
DI void phase_ssm2(const Params& p) {
    const int lane = TID_ & 63, gw = BID_ * 4 + (TID_ >> 6), nw = GDIM_ * 4;
    const float* SEND = (const float*)(p.ws + OFF_OS + T_SEND); float* CARRY = (float*)(p.ws + OFF_OS + T_CARRY);
    for (int item = gw; item < 96; item += nw) {
        const int dg = item % 48;
        const float* a64 = (const float*)(p.ws + OFF_A64) + (size_t)(dg * 64 + lane) * 2;
        const float ar = a64[0], ai = a64[1];
        float sr = 0.f, si = 0.f;
        const size_t base = (size_t)item * 132;
#pragma unroll 12
        for (int q = 0; q < 132; ++q) {
            const size_t o = ((base + q) * 64 + lane) * 2;
            const float er = SEND[o], ei = SEND[o + 1];
            CARRY[o] = sr; CARRY[o + 1] = si;
            const float nr = ar * sr - ai * si + er, ni = ar * si + ai * sr + ei;
            sr = nr; si = ni;
        }
    }
}
template <int DIR>
DI void ssm3_dir(const Params& p, const bf16_t* __restrict__ Z, const float* __restrict__ CARRY, const bf16_t* __restrict__ CXT, int b, int g, int c, int lane,
                 f32x4 (&acc)[4], float* BUs, unsigned* Sw) {
    const int l15 = lane & 15, quad = lane >> 4;
    bf16x8 bbf[8]; ssm_load_bbf(p, DIR * 24 + g, lane, bbf);
    const float* abar = (const float*)(p.ws + OFF_ABAR) + (size_t)((DIR * 24 + g) * 64 + lane) * 2;
    const float ar = abar[0], ai = abar[1];
    bf16x8 cf[4];
#pragma unroll
    for (int ks = 0; ks < 4; ++ks) cf[ks] = *(const bf16x8*)(CXT + (size_t)((DIR * 24 + g) * 16 + l15) * 128 + ks * 32 + quad * 8);
    const int q = DIR == 0 ? c : (c < 4 ? 3 - c : 135 - c);
    const float* cp = CARRY + ((size_t)(((b * 2 + DIR) * 24 + g) * 132 + q) * 64 + lane) * 2;
    float sr = cp[0], si = cp[1];
#pragma unroll
    for (int subi = 0; subi < 4; ++subi) {
        constexpr bool REV = DIR == 1;
        const int sub = REV ? 3 - subi : subi;
        ssm_sub<REV, true>(Z, b * TPB + c * 64 + sub * 16, g, bbf, ar, ai, sr, si, BUs, Sw, lane);
#pragma unroll
        for (int ks = 0; ks < 4; ++ks) {
            const bf16x8 sf = *(const bf16x8*)((const char*)Sw + l15 * 272 + ks * 64 + quad * 16);
            acc[sub] = MFMA16(cf[ks], sf, acc[sub]);
        }
        WAVE_SYNC
    }
}
DI void phase_ssm3(const Params& p, int l, char* smem) {
    const int lane = TID_ & 63, wave = TID_ >> 6, l15 = lane & 15, quad = lane >> 4;
    const int gw = BID_ * 4 + wave, nw = GDIM_ * 4;
    const bf16_t* Z = (const bf16_t*)(p.ws + OFF_Z); const float* CARRY = (const float*)(p.ws + OFF_OS + T_CARRY);
    bf16_t* YG = (bf16_t*)(p.ws + OFF_T + T_YG);
    const bf16_t* CXT = (const bf16_t*)(p.ws + OFF_CXT);
    const float* dvec = p.in[20] + l * 384;
    float* BUs = (float*)smem + wave * (16 * 132);
    unsigned* Sw = (unsigned*)(smem + 4 * 16 * 132 * 4) + wave * (16 * 68);
    for (int item = gw; item < 2 * 24 * 132; item += nw) {
        const int g = item % 24, c = (item / 24) % 132, b = item / (24 * 132);
        f32x4 acc[4];
#pragma unroll
        for (int i = 0; i < 4; ++i) acc[i] = (f32x4){0.f, 0.f, 0.f, 0.f};
        ssm3_dir<0>(p, Z, CARRY, CXT, b, g, c, lane, acc, BUs, Sw);
        ssm3_dir<1>(p, Z, CARRY, CXT, b, g, c, lane, acc, BUs, Sw);
#pragma unroll
        for (int sub = 0; sub < 4; ++sub) {
            const int row = b * TPB + c * 64 + sub * 16 + l15, ch = g * 16 + quad * 4;
            const uint2 zw = *(const uint2*)(Z + (size_t)row * 1440 + 1056 + ch);
            const f32x4 d = *(const f32x4*)(dvec + ch);
            float y[4] = {acc[sub][0] + d[0] * bflo(zw.x), acc[sub][1] + d[1] * bfhi(zw.x), acc[sub][2] + d[2] * bflo(zw.y), acc[sub][3] + d[3] * bfhi(zw.y)};
#pragma unroll
            for (int j = 0; j < 4; ++j) {
                const float x = y[j], inner = 0.7978845608028654f * (x + 0.044715f * x * x * x);
                const float th = 1.f - 2.f / (__expf(2.f * inner) + 1.f);
                y[j] = 0.5f * x * (1.f + th);
            }
            st_bf4(YG + (size_t)row * 384 + ch, y[0], y[1], y[2], y[3]);
        }
    }
}

DI void run_phase(const Params& p, int ph, char* smem, char* smem8) {
    if (ph == NPH - 1) { phase_final(p); return; }
    const int l = ph / NPH_LAYER;
#ifdef PH_ONLY
    const int k = PH_ONLY; if (ph % NPH_LAYER != PH_ONLY) return;
#else
    const int k = ph % NPH_LAYER;
#endif
#ifdef PH_SKIP
    if (k == PH_SKIP) return;
#endif
#ifdef PH_SKIP2
    if (k == PH_SKIP2) return;
#endif
    switch (k) {
        case 0: phase_prep(p, l, smem); break;
        case 1: phase_norm(p, l, 0); break;
        case 2: phase_gemm_z(p, smem8); break;
        case 3: phase_znorm(p, l); break;
        case 4: phase_gemm_qkv(p, smem); break;
        case 5: phase_four1(p, l, smem); phase_ssm1(p, smem); break;
        case 6: phase_ssm2(p); phase_four2(p, l, smem); break;
        case 7: phase_ssm3(p, l, smem); __syncthreads(); phase_attn(p, l, smem); break;
        case 8: phase_gemm_glu(p, l, smem); break;
        case 9: phase_merge(p, l, smem, smem8); break;
        case 10: phase_gemm_res(p, l, 0, smem, smem8); break;
        case 11: phase_norm(p, l, 1); break;
        case 12: phase_mlp1(p, l, smem, smem8); break;
        default: phase_gemm_res(p, l, 1, smem, smem8); break;
    }
}

#define XB_TMO      128
#define XB_XCNT(j)  (256  + 64 * (j))
#define XB_XSUB(j)  (1280 + 64 * (j))
#define XB_XGEN(j)  (2304 + 64 * (j))
#define XB_TOP      3328
#define XB_TOPGEN   3392
#define XCD_BAR_WORDS 3456
#define XB_SPIN_CAP (1u << 22)
#define LAS __attribute__((address_space(3)))
DI unsigned xb_ld(unsigned* p) { return __hip_atomic_load(p, __ATOMIC_RELAXED, __HIP_MEMORY_SCOPE_AGENT); }
DI unsigned xb_add(unsigned* p, unsigned v) { return __hip_atomic_fetch_add(p, v, __ATOMIC_RELAXED, __HIP_MEMORY_SCOPE_AGENT); }
DI unsigned xb_xcc_id() { return (unsigned)__builtin_amdgcn_s_getreg((3 << 11) | 20) & 0xFu; }
#define XB_SPIN(cond, bar) do { unsigned _sp = 0; while (cond) { __builtin_amdgcn_s_sleep(1); \
    if ((++_sp & 255u) == 0u) { if (xb_ld(&(bar)[XB_TMO])) break; if (_sp > XB_SPIN_CAP) { atomicAdd(&(bar)[XB_TMO], 1u); break; } } } } while (0)
struct XcdBarrier { unsigned* bar; unsigned x; volatile LAS unsigned* st; };
DI XcdBarrier xcd_barrier_post(unsigned* bar, volatile LAS unsigned* st) {
    XcdBarrier b; b.bar = bar; b.x = xb_xcc_id(); b.st = st;
    if (threadIdx.x == 0) (void)xb_add(&bar[XB_XCNT(b.x)], 1u);
    return b;
}
DI void xcd_barrier_complete(unsigned* bar, unsigned x, unsigned& nloc, unsigned& nx) {
    const unsigned G = gridDim.x * gridDim.y * gridDim.z;
    unsigned sum, cnt, mine, sp = 0u;
    for (;;) {
        sum = 0u; cnt = 0u; mine = 0u;
#pragma unroll
        for (unsigned j = 0; j < 16; ++j) { const unsigned c = xb_ld(&bar[XB_XCNT(j)]); sum += c; cnt += (c > 0u) ? 1u : 0u; mine = (j == x) ? c : mine; }
        if (sum == G) break;
        __builtin_amdgcn_s_sleep(1);
        if ((++sp & 255u) == 0u) { if (xb_ld(&bar[XB_TMO])) break; if (sp > XB_SPIN_CAP) { atomicAdd(&bar[XB_TMO], 1u); break; } }
    }
    nloc = mine > 0u ? mine : 1u; nx = cnt > 0u ? cnt : 1u;
}
DI void xcd_barrier(const XcdBarrier& b) {
    asm volatile("s_waitcnt vmcnt(0)" ::: "memory");
    __syncthreads();
    if (threadIdx.x == 0) {
        size_t zb_ = 0; asm volatile("" : "+s"(zb_));
        unsigned* bar = b.bar + zb_;
        __builtin_amdgcn_s_waitcnt(0);
        unsigned nloc = b.st[0], nx = b.st[1];
        if (nloc == 0u) { xcd_barrier_complete(bar, b.x, nloc, nx); b.st[0] = nloc; b.st[1] = nx; }
        const unsigned old = xb_add(&bar[XB_XSUB(b.x)], 1u);
        const unsigned gen = old / nloc;
        if (old + 1u == (gen + 1u) * nloc) {
            __builtin_amdgcn_fence(__ATOMIC_RELEASE, "agent");
            asm volatile("s_waitcnt vmcnt(0)" ::: "memory");
            const unsigned og = xb_add(&bar[XB_TOP], 1u);
            const unsigned tg = og / nx;
            if (og + 1u == (tg + 1u) * nx) xb_add(&bar[XB_TOPGEN], 1u);
            else XB_SPIN(xb_ld(&bar[XB_TOPGEN]) == tg, bar);
            __builtin_amdgcn_fence(__ATOMIC_ACQUIRE, "agent");
            xb_add(&bar[XB_XGEN(b.x)], 1u);
            asm volatile("s_waitcnt vmcnt(0)" ::: "memory");
        } else {
            XB_SPIN(xb_ld(&bar[XB_XGEN(b.x)]) == gen, bar);
            __builtin_amdgcn_fence(__ATOMIC_ACQUIRE, "agent");
            asm volatile("s_waitcnt vmcnt(0)" ::: "memory");
        }
    }
    __syncthreads();
}
__global__ void __launch_bounds__(512, 2) mk_fwd(Params p) {
    __shared__ __attribute__((aligned(16))) char smem[SMEM_BYTES];
    __shared__ uint4 xb_words;
    if (threadIdx.x == 0) xb_words = make_uint4(0u, 0u, 0u, 0u);
    __syncthreads();
    XcdBarrier xb = xcd_barrier_post((unsigned*)(p.ws + OFF_BAR), (volatile LAS unsigned*)&xb_words);
    for (int ph = p.lo; ph < p.hi; ++ph) {
        size_t zoff_ = 0; asm volatile("" : "+s"(zoff_));
        Params q = p; q.ws = p.ws + zoff_; q.out = p.out + zoff_;
        run_phase(q, ph, smem + HALF_ * SMEM_HALF, smem);
        if (ph + 1 < p.hi) {
            if (ph == p.lo) cg::this_grid().sync();
            else xcd_barrier(xb);
        }
    }
}

extern "C" void kernel_launch(void* const* d_in, const int* in_sizes, int n_in, void* d_out, int out_size, void* d_ws, size_t ws_size, hipStream_t stream) {
    static int grid_blocks = 0;
    if (!grid_blocks) {
        int dev = 0, cus = 0, per_cu = 0;
        hipGetDevice(&dev);
        hipDeviceGetAttribute(&cus, hipDeviceAttributeMultiprocessorCount, dev);
        hipOccupancyMaxActiveBlocksPerMultiprocessor(&per_cu, (const void*)mk_fwd, 512, 0);
        if (per_cu > 1) per_cu = 1;
        if (per_cu < 1) per_cu = 1;
        grid_blocks = cus * per_cu;
    }
    Params p{};
    for (int i = 0; i < 32; ++i) p.in[i] = (const float*)d_in[i];
    p.out = (float*)d_out; p.ws = (char*)d_ws;
#if MULTI_LAUNCH
    for (int ph = 0; ph < NPH; ++ph) {
        p.lo = ph; p.hi = ph + 1;
        hipLaunchKernelGGL(mk_fwd, dim3(grid_blocks), dim3(512), 0, stream, p);
    }
#else
    p.lo = 0; p.hi = NPH;
    hipMemsetAsync((char*)d_ws + OFF_BAR, 0, 16384, stream);
    void* args[] = {&p};
    hipError_t e = hipLaunchCooperativeKernel((const void*)mk_fwd, dim3(grid_blocks), dim3(512), args, 0, stream);
    if (e != hipSuccess) fprintf(stderr, "cooperative launch failed: %s (grid %d)\n", hipGetErrorString(e), grid_blocks);
#endif
}
```

```cpp
#include <hip/hip_runtime.h>
#include <hip/hip_cooperative_groups.h>
#include <stdint.h>
#include <stdio.h>
namespace cg = cooperative_groups;

#ifndef MULTI_LAUNCH
#define MULTI_LAUNCH 0
#endif

typedef unsigned short bf16_t;
typedef short bf16x8 __attribute__((ext_vector_type(8)));
typedef float f32x4 __attribute__((ext_vector_type(4)));
typedef unsigned u32x4 __attribute__((ext_vector_type(4)));
#define DI __device__ __forceinline__
#define BID_ ({ int z_ = 0; asm volatile("" : "+s"(z_)); (int)blockIdx.x * 2 + HALF_ + z_; })
#define GDIM_ ({ int z_ = 0; asm volatile("" : "+s"(z_)); (int)gridDim.x * 2 + z_; })
#define HALF_ ({ int zh_ = 0; asm volatile("" : "+s"(zh_)); (int)__builtin_amdgcn_readfirstlane((int)(threadIdx.x >> 8) + zh_); })
#define TID_ ({ int z_ = 0; asm volatile("" : "+s"(z_)); (int)(threadIdx.x & 255) + z_; })
#define TID8_ ({ int z_ = 0; asm volatile("" : "+s"(z_)); (int)threadIdx.x + z_; })
#define PBID_ ({ int z_ = 0; asm volatile("" : "+s"(z_)); (int)blockIdx.x + z_; })
#define PGDIM_ ({ int z_ = 0; asm volatile("" : "+s"(z_)); (int)gridDim.x + z_; })
#define MFMA16(a, b, c) __builtin_amdgcn_mfma_f32_16x16x32_bf16((a), (b), (c), 0, 0, 0)

constexpr int TPB = 8448, R = 16896, SEQ = 8192, CTX = 256;
constexpr int NPH_LAYER = 14, NPH = 2 * NPH_LAYER + 1;
constexpr size_t al256(size_t x) { return (x + 255) & ~(size_t)255; }
constexpr int LD1 = 1088, LD4 = 4160;
constexpr size_t WO_IN = 0, WO_GATE = WO_IN + 1440 * LD1, WO_UQ = WO_GATE + 3072 * LD1, WO_K = WO_UQ + 768 * 384,
                 WO_V = WO_K + 512 * 256, WO_GLU = WO_V + 512 * 256, WO_BA = WO_GLU + 384 * 384, WO_BF = WO_BA + 1024 * 512,
                 WO_BS = WO_BF + 1024 * 384, WO_OUT = WO_BS + 1024 * 384, WO_1 = WO_OUT + 1024 * LD1, WO_2 = WO_1 + 4096 * LD1,
                 WO_END = WO_2 + 1024 * LD4;
constexpr size_t OFF_H = 0;
constexpr size_t OFF_W = OFF_H + (size_t)R * LD1 * 2;
constexpr size_t OFF_XC = OFF_W + WO_END * 2;
constexpr size_t OFF_MOD = OFF_XC + 512 * 1024 * 4;
constexpr size_t OFF_ROPE = OFF_MOD + al256(2 * 3 * 6144 * 4);
constexpr size_t OFF_TW8192 = OFF_ROPE + 2 * 8192 * 16 * 4;
constexpr size_t OFF_TW256 = OFF_TW8192 + 8192 * 2 * 4;
constexpr size_t OFF_T0 = OFF_TW256 + 256 * 2 * 4;
constexpr size_t OFF_T1L = OFF_T0 + 128 * 64 * 2;
constexpr size_t OFF_T1C = OFF_T1L + 256 * 256 * 2;
constexpr size_t OFF_T2L = OFF_T1C + 32 * 32 * 2;
constexpr size_t OFF_T2C = OFF_T2L + 64 * 128 * 2;
constexpr size_t OFF_ABAR = OFF_T2C + 16 * 32 * 2;
constexpr size_t OFF_A64 = OFF_ABAR + 2 * 24 * 64 * 2 * 4;
constexpr size_t OFF_BBAR = OFF_A64 + 2 * 24 * 64 * 2 * 4;
constexpr size_t OFF_CXT = OFF_BBAR + 2 * 24 * 64 * 32 * 4;
constexpr size_t OFF_Z = al256(OFF_CXT + 2 * 24 * 16 * 128 * 2);
constexpr size_t OFF_T = OFF_Z + (size_t)R * 1440 * 2;
constexpr size_t SZ_T = 25952256;
constexpr size_t OFF_Q = OFF_T + SZ_T;
constexpr size_t OFF_K = OFF_Q + (size_t)R * 768 * 2;
constexpr size_t OFF_VT = OFF_K + (size_t)R * 768 * 2;
constexpr size_t OFF_OA = OFF_VT + (size_t)2 * 8 * 64 * TPB * 2;
constexpr size_t OFF_OF = OFF_OA + (size_t)R * 512 * 2;
constexpr size_t OFF_OS = OFF_OF + (size_t)R * 384 * 2;
constexpr size_t OFF_END = OFF_OS + (size_t)R * 384 * 2;
constexpr size_t OFF_BAR = OFF_END;
static_assert(OFF_BAR + 16384 <= 268435456, "workspace too large");
constexpr size_t T_QIN = 0, T_CKV = (size_t)R * 384 * 2;
constexpr size_t T_F1L = 0, T_F1C = (size_t)2 * 8192 * 768 * 2;
constexpr size_t T_SEND = 0, T_CARRY = (size_t)2 * 2 * 24 * 132 * 64 * 2 * 4, T_YG = 2 * T_CARRY;
static_assert(T_YG + (size_t)R * 384 * 2 <= SZ_T && T_F1C + (size_t)2 * 256 * 768 * 2 <= SZ_T, "T region");
static_assert((size_t)R * LD4 * 2 <= OFF_OA - OFF_Z, "U alias");

constexpr int SMEM_HALF = 69632, SMEM_BYTES = 2 * SMEM_HALF;

struct Params { const float* in[32]; float* out; char* ws; int lo, hi; };

DI bf16_t f2bf(float x) { unsigned u = __float_as_uint(x); u += 0x7fffu + ((u >> 16) & 1u); return (bf16_t)(u >> 16); }
DI float bf2f(bf16_t h) { return __uint_as_float(((unsigned)h) << 16); }
typedef __bf16 bf2_t __attribute__((ext_vector_type(2)));
typedef float f2_t __attribute__((ext_vector_type(2)));
DI unsigned pack2(float a, float b) { f2_t v = {a, b}; bf2_t r = __builtin_convertvector(v, bf2_t); return __builtin_bit_cast(unsigned, r); }
DI float bflo(unsigned w) { return __uint_as_float(w << 16); }
DI float bfhi(unsigned w) { return __uint_as_float(w & 0xffff0000u); }
DI float max3f(float a, float b, float c) { float r; asm("v_max3_f32 %0, %1, %2, %3" : "=v"(r) : "v"(a), "v"(b), "v"(c)); return r; }
DI float sigmoidf_(float x) { return 1.f / (1.f + __expf(-x)); }
DI float shx(float v, int mask) {
    unsigned z_ = 0; asm volatile("" : "+s"(z_));
    const int lane = (int)__builtin_amdgcn_mbcnt_hi(~0u, __builtin_amdgcn_mbcnt_lo(~0u, z_));
    return __int_as_float(__builtin_amdgcn_ds_bpermute((lane ^ mask) << 2, __float_as_int(v)));
}
DI float wave_sum(float v) {
#pragma unroll
    for (int o = 32; o >= 1; o >>= 1) v += shx(v, o);
    return v;
}
DI float* xptr(const Params& p, bool orig, int row) {
    const int b = row / TPB, t = row - b * TPB;
    if (t < CTX) { float* base = orig ? (float*)p.in[2] : (float*)(p.ws + OFF_XC); return base + (size_t)(b * CTX + t) * 1024; }
    float* base = orig ? (float*)p.in[0] : p.out; return base + (size_t)(b * SEQ + t - CTX) * 1024;
}
DI int srow_of(int row) { const int b = row / TPB, t = row - b * TPB; return t < CTX ? 2 : b; }

DI void gemm_main(f32x4 (&acc)[4][4], const bf16_t* __restrict__ A, int lda, int arows, const bf16_t* __restrict__ B, int ldb, int brows,
                  int K, int row0, int col0, char* smem) {
    const int tid = TID_, lane = tid & 63, wave = tid >> 6, l15 = lane & 15, quad = lane >> 4, wm = wave >> 1, wn = wave & 1;
    __builtin_amdgcn_sched_barrier(0);
    char* As = smem;
    char* Bs = smem + 32768;
#pragma unroll
    for (int i = 0; i < 4; ++i)
#pragma unroll
        for (int j = 0; j < 4; ++j) acc[i][j] = (f32x4){0.f, 0.f, 0.f, 0.f};
    const int sb = lane * 16, swz = sb ^ (((sb >> 9) & 1) << 5), sr = swz >> 6, sk = (swz & 63) >> 1;
    const bf16_t* pa[4]; const bf16_t* pb[4];
#pragma unroll
    for (int i = 0; i < 4; ++i) {
        const int st = wave + 4 * i, rr = (st >> 1) * 16 + sr, kk = (st & 1) * 32 + sk;
        pa[i] = A + (size_t)min(row0 + rr, arows - 1) * lda + kk;
        pb[i] = B + (size_t)min(col0 + rr, brows - 1) * ldb + kk;
    }
    const int wofs = wave * 1024 + lane * 16;
    const int lo = (l15 * 64 + quad * 16) ^ ((l15 >> 3) << 5);
    u32x4 ra[4], rb[4];
#define G_ISSUE(k0) _Pragma("unroll") for (int i = 0; i < 4; ++i) { ra[i] = *(const u32x4*)(pa[i] + (k0)); rb[i] = *(const u32x4*)(pb[i] + (k0)); }
#define G_WRITE(buf) _Pragma("unroll") for (int i = 0; i < 4; ++i) { *(u32x4*)(As + (buf)*16384 + i * 4096 + wofs) = ra[i]; *(u32x4*)(Bs + (buf)*16384 + i * 4096 + wofs) = rb[i]; }
    const int KT = K >> 6;
    G_ISSUE(0)
    G_WRITE(0)
    if (KT > 1) { G_ISSUE(64) }
    __syncthreads();
    for (int kt = 0; kt < KT; ++kt) {
        const int cur = kt & 1;
#pragma unroll
        for (int ks = 0; ks < 2; ++ks) {
            if (ks == 1) {
                if (kt + 1 < KT) { G_WRITE(cur ^ 1) }
                if (kt + 2 < KT) { G_ISSUE((kt + 2) * 64) }
            }
            bf16x8 af[4], bfr[4];
#pragma unroll
            for (int mi = 0; mi < 4; ++mi) af[mi] = *(const bf16x8*)(As + cur * 16384 + ((wm * 4 + mi) * 2 + ks) * 1024 + lo);
#pragma unroll
            for (int ni = 0; ni < 4; ++ni) bfr[ni] = *(const bf16x8*)(Bs + cur * 16384 + ((wn * 4 + ni) * 2 + ks) * 1024 + lo);
#pragma unroll
            for (int mi = 0; mi < 4; ++mi)
#pragma unroll
                for (int ni = 0; ni < 4; ++ni) acc[mi][ni] = MFMA16(bfr[ni], af[mi], acc[mi][ni]);
            __builtin_amdgcn_sched_barrier(0);
        }
        __syncthreads();
    }
#undef G_ISSUE
#undef G_WRITE
}
DI void gemm_main2(f32x4 (&acc)[8][4], const bf16_t* __restrict__ A, int lda, int arows, const bf16_t* __restrict__ B, int ldb, int brows,
                   int K, int row0, int col0, char* smem) {
    const int tid = TID_, lane = tid & 63, wave = tid >> 6, l15 = lane & 15, quad = lane >> 4, wm = wave >> 1, wn = wave & 1;
    __builtin_amdgcn_sched_barrier(0);
    char* As = smem;
    char* Bs = smem + 32768;
#pragma unroll
    for (int i = 0; i < 8; ++i)
#pragma unroll
        for (int j = 0; j < 4; ++j) acc[i][j] = (f32x4){0.f, 0.f, 0.f, 0.f};
    const int sb = lane * 16, swz = sb ^ (((sb >> 9) & 1) << 5), sr = swz >> 6, sk = (swz & 63) >> 1;
    const bf16_t* pa[4]; const bf16_t* pb[2];
#pragma unroll
    for (int i = 0; i < 4; ++i) pa[i] = A + (size_t)min(row0 + (wave + 4 * i) * 16 + sr, arows - 1) * lda + sk;
#pragma unroll
    for (int i = 0; i < 2; ++i) pb[i] = B + (size_t)min(col0 + (wave + 4 * i) * 16 + sr, brows - 1) * ldb + sk;
    const int wofs = wave * 1024 + lane * 16;
    const int lo = (l15 * 64 + quad * 16) ^ ((l15 >> 3) << 5);
    u32x4 ra[4], rb[2];
#define G_ISSUE(k0) { _Pragma("unroll") for (int i = 0; i < 4; ++i) ra[i] = *(const u32x4*)(pa[i] + (k0)); _Pragma("unroll") for (int i = 0; i < 2; ++i) rb[i] = *(const u32x4*)(pb[i] + (k0)); }
#define G_WRITE(buf) { _Pragma("unroll") for (int i = 0; i < 4; ++i) *(u32x4*)(As + (buf)*16384 + i * 4096 + wofs) = ra[i]; _Pragma("unroll") for (int i = 0; i < 2; ++i) *(u32x4*)(Bs + (buf)*8192 + i * 4096 + wofs) = rb[i]; }
    const int KT = K >> 5;
    G_ISSUE(0)
    G_WRITE(0)
    if (KT > 1) G_ISSUE(32)
    __syncthreads();
    for (int kt = 0; kt < KT; ++kt) {
        const int cur = kt & 1;
        bf16x8 bfr[4];
#pragma unroll
        for (int ni = 0; ni < 4; ++ni) bfr[ni] = *(const bf16x8*)(Bs + cur * 8192 + (wn * 4 + ni) * 1024 + lo);
#pragma unroll
        for (int mi = 0; mi < 4; ++mi) {
            const bf16x8 af = *(const bf16x8*)(As + cur * 16384 + (wm * 8 + mi) * 1024 + lo);
#pragma unroll
            for (int ni = 0; ni < 4; ++ni) acc[mi][ni] = MFMA16(bfr[ni], af, acc[mi][ni]);
        }
        __builtin_amdgcn_sched_barrier(0);
        if (kt + 1 < KT) G_WRITE(cur ^ 1)
        if (kt + 2 < KT) G_ISSUE((kt + 2) * 32)
#pragma unroll
        for (int mi = 4; mi < 8; ++mi) {
            const bf16x8 af = *(const bf16x8*)(As + cur * 16384 + (wm * 8 + mi) * 1024 + lo);
#pragma unroll
            for (int ni = 0; ni < 4; ++ni) acc[mi][ni] = MFMA16(bfr[ni], af, acc[mi][ni]);
        }
        __syncthreads();
    }
#undef G_ISSUE
#undef G_WRITE
}
#define EPI2_ROW(mi) (row0 + wm_ * 128 + (mi)*16 + l15_)
DI void gemm_main3(f32x4 (&acc)[8][4], const bf16_t* __restrict__ A, int lda, int arows, const bf16_t* __restrict__ B, int ldb, int brows,
                   int K, int row0, int col0, char* smem8) {
    const int tid = TID8_, lane = tid & 63, wave = tid >> 6, l15 = lane & 15, quad = lane >> 4, wr = wave >> 2, wc = wave & 3;
    __builtin_amdgcn_sched_barrier(0);
    char* As = smem8;
    char* Bs = smem8 + 65536;
#pragma unroll
    for (int i = 0; i < 8; ++i)
#pragma unroll
        for (int j = 0; j < 4; ++j) acc[i][j] = (f32x4){0.f, 0.f, 0.f, 0.f};
    const int sb = lane * 16, swz = sb ^ (((sb >> 9) & 1) << 5), sr = swz >> 6, sk = (swz & 63) >> 1;
    const bf16_t* pa[4]; const bf16_t* pb[4];
#pragma unroll
    for (int i = 0; i < 4; ++i) {
        const int st = wave + 8 * i, rr = (st >> 1) * 16 + sr, kk = (st & 1) * 32 + sk;
        pa[i] = A + (size_t)min(row0 + rr, arows - 1) * lda + kk;
        pb[i] = B + (size_t)min(col0 + rr, brows - 1) * ldb + kk;
    }
    const int wofs = wave * 1024 + lane * 16;
    const int lo = (l15 * 64 + quad * 16) ^ ((l15 >> 3) << 5);
    u32x4 ra[4], rb[4];
#define G_ISSUE(k0) { _Pragma("unroll") for (int i = 0; i < 4; ++i) { ra[i] = *(const u32x4*)(pa[i] + (k0)); rb[i] = *(const u32x4*)(pb[i] + (k0)); } }
#define G_WRITE(buf) { _Pragma("unroll") for (int i = 0; i < 4; ++i) { *(u32x4*)(As + (buf)*32768 + i * 8192 + wofs) = ra[i]; *(u32x4*)(Bs + (buf)*32768 + i * 8192 + wofs) = rb[i]; } }
    const int KT = K >> 6;
    G_ISSUE(0)
    G_WRITE(0)
    if (KT > 1) G_ISSUE(64)
    __syncthreads();
    for (int kt = 0; kt < KT; ++kt) {
        const int cur = kt & 1;
#pragma unroll
        for (int ks = 0; ks < 2; ++ks) {
            if (ks == 1) {
                if (kt + 1 < KT) G_WRITE(cur ^ 1)
                if (kt + 2 < KT) G_ISSUE((kt + 2) * 64)
            }
            bf16x8 bfr[4];
#pragma unroll
            for (int ni = 0; ni < 4; ++ni) bfr[ni] = *(const bf16x8*)(Bs + cur * 32768 + ((wc * 4 + ni) * 2 + ks) * 1024 + lo);
#pragma unroll
            for (int mi = 0; mi < 8; ++mi) {
                const bf16x8 af = *(const bf16x8*)(As + cur * 32768 + ((wr * 8 + mi) * 2 + ks) * 1024 + lo);
#pragma unroll
                for (int ni = 0; ni < 4; ++ni) acc[mi][ni] = MFMA16(bfr[ni], af, acc[mi][ni]);
            }
            __builtin_amdgcn_sched_barrier(0);
        }
        __syncthreads();
    }
#undef G_ISSUE
#undef G_WRITE
}
#define EPI8_VARS const int tid8_ = TID8_, lane8_ = tid8_ & 63, wave8_ = tid8_ >> 6, l15e_ = lane8_ & 15, quade_ = lane8_ >> 4, wr_ = wave8_ >> 2, wc_ = wave8_ & 3;
#define EPI8_ROW(mi) (row0 + wr_ * 128 + (mi)*16 + l15e_)
#define EPI8_COL(ni) (col0 + wc_ * 64 + (ni)*16 + quade_ * 4)
#define EPI_VARS const int tid_ = TID_, lane_ = tid_ & 63, wave_ = tid_ >> 6, l15_ = lane_ & 15, quad_ = lane_ >> 4, wm_ = wave_ >> 1, wn_ = wave_ & 1; (void)l15_; (void)quad_; (void)wm_; (void)wn_;
#define EPI_ROW(mi) (row0 + wm_ * 64 + (mi)*16 + l15_)
#define EPI_COL(ni) (col0 + wn_ * 64 + (ni)*16 + quad_ * 4)
DI void st_bf4(bf16_t* dst, float a, float b, float c, float d) { uint2 w; w.x = pack2(a, b); w.y = pack2(c, d); *(uint2*)dst = w; }
template <int MI>
DI void stage_tile_bf16(const f32x4 (&acc)[MI][4], char* smem, bf16_t* __restrict__ dst, int ld, int row0, int col0, int ncols, bool kmap = false) {
    const int tid = TID_, lane = tid & 63, wave = tid >> 6, l15 = lane & 15, quad = lane >> 4, wm = wave >> 1, wn = wave & 1;
    bf16_t* T = (bf16_t*)smem;
#pragma unroll
    for (int mi = 0; mi < MI; ++mi)
#pragma unroll
        for (int ni = 0; ni < 4; ++ni) {
            uint2 w; w.x = pack2(acc[mi][ni][0], acc[mi][ni][1]); w.y = pack2(acc[mi][ni][2], acc[mi][ni][3]);
            *(uint2*)&T[(wm * (MI * 16) + mi * 16 + l15) * 136 + wn * 64 + ni * 16 + quad * 4] = w;
        }
    __syncthreads();
#pragma unroll
    for (int i = 0; i < MI * 2; ++i) {
        const int c = tid + 256 * i, r = c >> 4, part = c & 15;
        const int cc_ = col0 + part * 8, dc_ = kmap ? (cc_ >> 6) * 96 + (cc_ & 63) : cc_;
        if (cc_ < ncols) *(u32x4*)(dst + (size_t)(row0 + r) * ld + dc_) = *(const u32x4*)&T[r * 136 + part * 8];
    }
    __syncthreads();
}

DI void stage_tile8(const f32x4 (&acc)[8][4], char* smem8, bf16_t* __restrict__ dst, int ld, int row0, int col0, int ncols) {
    const int tid = TID8_, lane = tid & 63, wave = tid >> 6, l15 = lane & 15, quad = lane >> 4, wr = wave >> 2, wc = wave & 3;
    bf16_t* T = (bf16_t*)smem8;
#pragma unroll
    for (int mi = 0; mi < 8; ++mi)
#pragma unroll
        for (int ni = 0; ni < 4; ++ni) {
            uint2 w; w.x = pack2(acc[mi][ni][0], acc[mi][ni][1]); w.y = pack2(acc[mi][ni][2], acc[mi][ni][3]);
            *(uint2*)&T[(wr * 128 + mi * 16 + l15) * 264 + wc * 64 + ni * 16 + quad * 4] = w;
        }
    __syncthreads();
#pragma unroll
    for (int i = 0; i < 16; ++i) {
        const int c = tid + 512 * i, r = c >> 5, part = c & 31;
        if (col0 + part * 8 < ncols) *(u32x4*)(dst + (size_t)(row0 + r) * ld + col0 + part * 8) = *(const u32x4*)&T[r * 264 + part * 8];
    }
    __syncthreads();
}
DI void conv_job(const float* __restrict__ W, int K, int N, int ldw, int mode, bf16_t* __restrict__ Wt, int ldo, char* smem) {
    const int tid = TID_;
    bf16_t* T = (bf16_t*)smem;
    const int tn = N >> 5, ntiles = (K >> 6) * tn;
    const int kk = tid >> 3, n4 = (tid & 7) * 4;
    const int bid = BID_, gstep = GDIM_;
    f32x4 v0 = {0.f, 0.f, 0.f, 0.f}, v1 = v0;
    auto src_of = [&](int t) -> const float* {
        const int k0 = (t / tn) * 64, nn = (t % tn) * 32 + n4;
        const int sc = mode == 0 ? nn : ((nn >> 6) * 128 + (nn & 63) + (mode == 2 ? 64 : 0));
        return W + (size_t)(k0 + kk) * ldw + sc;
    };
    if (bid < ntiles) { const float* sp = src_of(bid); v0 = *(const f32x4*)sp; v1 = *(const f32x4*)(sp + (size_t)32 * ldw); }
    for (int t = bid; t < ntiles; t += gstep) {
        f32x4 w0 = v0, w1 = v1;
        if (t + gstep < ntiles) { const float* sp = src_of(t + gstep); v0 = *(const f32x4*)sp; v1 = *(const f32x4*)(sp + (size_t)32 * ldw); }
        const int k0 = (t / tn) * 64, n0 = (t % tn) * 32;
#pragma unroll
        for (int j = 0; j < 4; ++j) { T[(n4 + j) * 72 + kk] = f2bf(w0[j]); T[(n4 + j) * 72 + kk + 32] = f2bf(w1[j]); }
        __syncthreads();
        const int n = tid >> 3, kq = (tid & 7) * 8;
        *(u32x4*)(Wt + (size_t)(n0 + n) * ldo + k0 + kq) = *(const u32x4*)&T[n * 72 + kq];
        __syncthreads();
    }
}
DI void gen_t1(bf16_t* T, int N1, int gtid, int gthreads) {
    const int S = 2 * N1;
    for (int i = gtid; i < S * S; i += gthreads) {
        const int m2 = i / S, kk = i % S, k1 = m2 >> 1, ro = m2 & 1, n1 = kk >> 1, ri = kk & 1;
        const int q = (n1 * k1) % N1; float s, c; sincospif(2.f * (float)q / (float)N1, &s, &c);
        const float v = ro == 0 ? (ri == 0 ? c : s) : (ri == 0 ? -s : c);
        T[i] = f2bf(v);
    }
}
DI void gen_t2(bf16_t* T, int N2, int gtid, int gthreads) {
    const int S = 2 * N2;
    for (int i = gtid; i < N2 * S; i += gthreads) {
        const int k2 = i / S, kk = i % S, n2 = kk >> 1, ri = kk & 1;
        const int q = (n2 * k2) % N2; float s, c; sincospif(2.f * (float)q / (float)N2, &s, &c);
        T[i] = f2bf(ri == 0 ? c : s);
    }
}
DI void phase_prep(const Params& p, int l, char* smem) {
    const int tid = TID_, lane = tid & 63, wave = tid >> 6;
    const int gtid = BID_ * 256 + tid, gthreads = GDIM_ * 256;
    char* ws = p.ws;
    if (l == 0) {
        float* sil = (float*)smem;
        float* red = sil + 3072;
        for (int item = BID_; item < 192; item += GDIM_) {
            const int ll = item / 96, cgp = item % 96;
            for (int i = tid; i < 3072; i += 256) {
                const int s = i >> 10, k = i & 1023;
                const float x = s < 2 ? p.in[1][s * 1024 + k] : p.in[3][k];
                sil[i] = x / (1.f + __expf(-x));
            }
            __syncthreads();
            const int col = cgp * 64 + lane;
            const float* wp = p.in[4] + (size_t)ll * 1024 * 6144 + col;
            float a0 = 0.f, a1 = 0.f, a2 = 0.f;
#pragma unroll 32
            for (int k = wave * 256; k < wave * 256 + 256; ++k) {
                const float w = wp[(size_t)k * 6144];
                a0 += sil[k] * w; a1 += sil[1024 + k] * w; a2 += sil[2048 + k] * w;
            }
            red[(wave * 3 + 0) * 64 + lane] = a0; red[(wave * 3 + 1) * 64 + lane] = a1; red[(wave * 3 + 2) * 64 + lane] = a2;
            __syncthreads();
            if (wave < 3) {
                const float v = red[(0 * 3 + wave) * 64 + lane] + red[(1 * 3 + wave) * 64 + lane] + red[(2 * 3 + wave) * 64 + lane] + red[(3 * 3 + wave) * 64 + lane];
                ((float*)(ws + OFF_MOD))[(size_t)(ll * 3 + wave) * 6144 + col] = v + p.in[5][ll * 6144 + col];
            }
            __syncthreads();
        }
        float* rc = (float*)(ws + OFF_ROPE); float* rs = rc + 8192 * 16;
        for (int i = gtid; i < 8192 * 16; i += gthreads) {
            const int t = i >> 4, ii = i & 15, m = ii & 7;
            const float inv = powf(10000.f, -(float)(2 * m) / 16.f);
            const float pos = (float)(ii < 8 ? (t >> 6) : (t & 63));
            const float ang = pos * inv;
            rc[i] = cosf(ang); rs[i] = sinf(ang);
        }
        float* tw = (float*)(ws + OFF_TW8192);
        for (int i = gtid; i < 8192; i += gthreads) { float s, c; sincospif(2.f * (float)i / 8192.f, &s, &c); tw[2 * i] = c; tw[2 * i + 1] = s; }
        float* tw2 = (float*)(ws + OFF_TW256);
        for (int i = gtid; i < 256; i += gthreads) { float s, c; sincospif(2.f * (float)i / 256.f, &s, &c); tw2[2 * i] = c; tw2[2 * i + 1] = s; }
        bf16_t* t0 = (bf16_t*)(ws + OFF_T0);
        for (int i = gtid; i < 128 * 64; i += gthreads) {
            const int c2 = i >> 6, j = i & 63, kp = c2 >> 1, ri = c2 & 1;
            float s, c; sincospif(2.f * (float)((j * kp) & 63) / 64.f, &s, &c);
            t0[i] = f2bf(ri == 0 ? c : -s);
        }
        gen_t1((bf16_t*)(ws + OFF_T1L), 128, gtid, gthreads);
        gen_t1((bf16_t*)(ws + OFF_T1C), 16, gtid, gthreads);
        gen_t2((bf16_t*)(ws + OFF_T2L), 64, gtid, gthreads);
        gen_t2((bf16_t*)(ws + OFF_T2C), 16, gtid, gthreads);
    }
    {
        float* abar = (float*)(ws + OFF_ABAR); float* a64 = (float*)(ws + OFF_A64); bf16_t* bbt = (bf16_t*)(ws + OFF_BBAR);
        for (int i = gtid; i < 2 * 24 * 64; i += gthreads) {
            const int n = i & 63, dg = i >> 6;
            const size_t pi = (size_t)l * 2 * 24 * 64 + i;
            const float are = p.in[13][pi], aim = p.in[14][pi];
            const float dt = expf(p.in[15][l * 48 + dg]);
            const float mag = expf(dt * are); float sn, cs; sincosf(dt * aim, &sn, &cs);
            const float br = mag * cs, bi = mag * sn;
            abar[2 * i] = br; abar[2 * i + 1] = bi;
            float pr = br, pim = bi;
#pragma unroll
            for (int k = 0; k < 6; ++k) { const float nr = pr * pr - pim * pim, ni = 2.f * pr * pim; pr = nr; pim = ni; }
            a64[2 * i] = pr; a64[2 * i + 1] = pim;
            const float nr = br - 1.f, ni = bi, den = are * are + aim * aim;
            const float cr = (nr * are + ni * aim) / den, ci = (ni * are - nr * aim) / den;
            const float* bre = p.in[16] + pi * 16; const float* bim = p.in[17] + pi * 16;
#pragma unroll
            for (int q = 0; q < 16; ++q) {
                const float xr = bre[q], xi = bim[q];
                bbt[((size_t)dg * 128 + 2 * n) * 16 + q] = f2bf(cr * xr - ci * xi);
                bbt[((size_t)dg * 128 + 2 * n + 1) * 16 + q] = f2bf(cr * xi + ci * xr);
            }
        }
        bf16_t* cxt = (bf16_t*)(ws + OFF_CXT);
        for (int i = gtid; i < 2 * 24 * 16 * 64; i += gthreads) {
            const size_t pi = (size_t)l * 2 * 24 * 16 * 64 + i;
            const int n = i & 63, dgp = i >> 6;
            cxt[(size_t)dgp * 128 + 2 * n] = f2bf(p.in[18][pi]);
            cxt[(size_t)dgp * 128 + 2 * n + 1] = f2bf(-p.in[19][pi]);
        }
    }
    bf16_t* W = (bf16_t*)(ws + OFF_W);
    conv_job(p.in[8] + (size_t)l * 1024 * 1440, 1024, 1440, 1440, 0, W + WO_IN, LD1, smem);
    conv_job(p.in[26] + (size_t)l * 1024 * 3072, 1024, 3072, 3072, 0, W + WO_GATE, LD1, smem);
    conv_job(p.in[10] + (size_t)l * 384 * 768, 384, 768, 768, 0, W + WO_UQ, 384, smem);
    conv_job(p.in[12] + (size_t)l * 256 * 1024, 256, 512, 1024, 1, W + WO_K, 256, smem);
    conv_job(p.in[12] + (size_t)l * 256 * 1024, 256, 512, 1024, 2, W + WO_V, 256, smem);
    conv_job(p.in[21] + (size_t)l * 384 * 384, 384, 384, 384, 0, W + WO_GLU, 384, smem);
    conv_job(p.in[23] + (size_t)l * 512 * 1024, 512, 1024, 1024, 0, W + WO_BA, 512, smem);
    conv_job(p.in[24] + (size_t)l * 384 * 1024, 384, 1024, 1024, 0, W + WO_BF, 384, smem);
    conv_job(p.in[25] + (size_t)l * 384 * 1024, 384, 1024, 1024, 0, W + WO_BS, 384, smem);
    conv_job(p.in[28] + (size_t)l * 1024 * 1024, 1024, 1024, 1024, 0, W + WO_OUT, LD1, smem);
    conv_job(p.in[29] + (size_t)l * 1024 * 4096, 1024, 4096, 4096, 0, W + WO_1, LD1, smem);
    conv_job(p.in[30] + (size_t)l * 4096 * 1024, 4096, 1024, 1024, 0, W + WO_2, LD4, smem);
}

DI void phase_norm(const Params& p, int l, int which) {
    const int lane = TID_ & 63, gw = BID_ * 4 + (TID_ >> 6), nw = GDIM_ * 4;
    const float* ln = p.in[which == 0 ? 6 : 7] + l * 1024;
    const bool orig = (which == 0 && l == 0);
    bf16_t* H = (bf16_t*)(p.ws + OFF_H);
    for (int row = gw; row < R; row += nw) {
        const float* x = xptr(p, orig, row);
        const float* mod = (const float*)(p.ws + OFF_MOD) + (size_t)(l * 3 + srow_of(row)) * 6144 + (which == 0 ? 0 : 3072);
        f32x4 v[4]; float ss = 0.f;
#pragma unroll
        for (int i = 0; i < 4; ++i) { v[i] = *(const f32x4*)(x + i * 256 + lane * 4); ss += v[i][0] * v[i][0] + v[i][1] * v[i][1] + v[i][2] * v[i][2] + v[i][3] * v[i][3]; }
        if (orig && (row % TPB) < CTX) {
            float* xc = xptr(p, false, row);
#pragma unroll
            for (int i = 0; i < 4; ++i) *(f32x4*)(xc + i * 256 + lane * 4) = v[i];
        }
        ss = wave_sum(ss);
        const float rstd = rsqrtf(ss * (1.f / 1024.f) + 1e-6f);
#pragma unroll
        for (int i = 0; i < 4; ++i) {
            const int c = i * 256 + lane * 4;
            const f32x4 g = *(const f32x4*)(ln + c), sh = *(const f32x4*)(mod + c), sc = *(const f32x4*)(mod + 1024 + c);
            float o[4];
#pragma unroll
            for (int j = 0; j < 4; ++j) o[j] = v[i][j] * rstd * g[j] * (1.f + sc[j]) + sh[j];
            st_bf4(H + (size_t)row * LD1 + c, o[0], o[1], o[2], o[3]);
        }
    }
}
DI void phase_final(const Params& p) {
    const int lane = TID_ & 63, gw = BID_ * 4 + (TID_ >> 6), nw = GDIM_ * 4;
    const float* fn = p.in[31];
    for (int r = gw; r < 2 * SEQ; r += nw) {
        float* x = p.out + (size_t)r * 1024;
        f32x4 v[4]; float ss = 0.f;
#pragma unroll
        for (int i = 0; i < 4; ++i) { v[i] = *(const f32x4*)(x + i * 256 + lane * 4); ss += v[i][0] * v[i][0] + v[i][1] * v[i][1] + v[i][2] * v[i][2] + v[i][3] * v[i][3]; }
        ss = wave_sum(ss);
        const float rstd = rsqrtf(ss * (1.f / 1024.f) + 1e-6f);
#pragma unroll
        for (int i = 0; i < 4; ++i) {
            const int c = i * 256 + lane * 4;
            const f32x4 g = *(const f32x4*)(fn + c);
            f32x4 o;
#pragma unroll
            for (int j = 0; j < 4; ++j) o[j] = v[i][j] * rstd * g[j];
            *(f32x4*)(x + c) = o;
        }
    }
}
DI void unpack8(u32x4 w, float (&v)[8]) { v[0] = bflo(w.x); v[1] = bfhi(w.x); v[2] = bflo(w.y); v[3] = bfhi(w.y); v[4] = bflo(w.z); v[5] = bfhi(w.z); v[6] = bflo(w.w); v[7] = bfhi(w.w); }
DI u32x4 pack8(const float (&v)[8]) { u32x4 w; w.x = pack2(v[0], v[1]); w.y = pack2(v[2], v[3]); w.z = pack2(v[4], v[5]); w.w = pack2(v[6], v[7]); return w; }
DI void phase_znorm(const Params& p, int l) {
    const int lane = TID_ & 63, gw = BID_ * 4 + (TID_ >> 6), nw = GDIM_ * 4;
    const bf16_t* Z = (const bf16_t*)(p.ws + OFF_Z);
    bf16_t* QIN = (bf16_t*)(p.ws + OFF_T + T_QIN); bf16_t* CKV = (bf16_t*)(p.ws + OFF_T + T_CKV); bf16_t* Kb = (bf16_t*)(p.ws + OFF_K);
    const float* qn = p.in[9] + l * 384; const float* kvn = p.in[11] + l * 256;
    const float* rc = (const float*)(p.ws + OFF_ROPE); const float* rs = rc + 8192 * 16;
    for (int row = gw; row < R; row += nw) {
        const bf16_t* z = Z + (size_t)row * 1440;
        float q[8], k[8], ssq = 0.f, ssk = 0.f;
        if (lane < 48) { unpack8(*(const u32x4*)(z + lane * 8), q);
#pragma unroll
            for (int j = 0; j < 8; ++j) ssq += q[j] * q[j]; }
        if (lane < 32) { unpack8(*(const u32x4*)(z + 384 + lane * 8), k);
#pragma unroll
            for (int j = 0; j < 8; ++j) ssk += k[j] * k[j]; }
        ssq = wave_sum(ssq); ssk = wave_sum(ssk);
        const float rq = rsqrtf(ssq * (1.f / 384.f) + 1e-6f), rk = rsqrtf(ssk * (1.f / 256.f) + 1e-6f);
        if (lane < 48) {
            const f32x4 g0 = *(const f32x4*)(qn + lane * 8), g1 = *(const f32x4*)(qn + lane * 8 + 4);
#pragma unroll
            for (int j = 0; j < 4; ++j) { q[j] *= rq * g0[j]; q[4 + j] *= rq * g1[j]; }
            *(u32x4*)(QIN + (size_t)row * 384 + lane * 8) = pack8(q);
        }
        if (lane < 32) {
            const f32x4 g0 = *(const f32x4*)(kvn + lane * 8), g1 = *(const f32x4*)(kvn + lane * 8 + 4);
#pragma unroll
            for (int j = 0; j < 4; ++j) { k[j] *= rk * g0[j]; k[4 + j] *= rk * g1[j]; }
            *(u32x4*)(CKV + (size_t)row * 256 + lane * 8) = pack8(k);
            const int h = lane >> 2, part = lane & 3, i0 = (part & 1) * 8, t = row % TPB;
            float x1[8], x2[8], o[8];
            unpack8(*(const u32x4*)(z + 640 + i0), x1); unpack8(*(const u32x4*)(z + 656 + i0), x2);
            if (t >= CTX) {
                const float* cp = rc + (size_t)(t - CTX) * 16 + i0; const float* sp = rs + (size_t)(t - CTX) * 16 + i0;
                const f32x4 c0 = *(const f32x4*)cp, c1 = *(const f32x4*)(cp + 4), s0 = *(const f32x4*)sp, s1 = *(const f32x4*)(sp + 4);
#pragma unroll
                for (int j = 0; j < 8; ++j) { const float c = j < 4 ? c0[j & 3] : c1[j & 3], s = j < 4 ? s0[j & 3] : s1[j & 3];
                    o[j] = part < 2 ? x1[j] * c - x2[j] * s : x2[j] * c + x1[j] * s; }
            } else {
#pragma unroll
                for (int j = 0; j < 8; ++j) o[j] = part < 2 ? x1[j] : x2[j];
            }
            *(u32x4*)(Kb + (size_t)row * 768 + h * 96 + 64 + part * 8) = pack8(o);
        }
    }
}

#define FOR_TILES(MT, NT, SN) \
    const int xcd_ = BID_ & 7, slot_ = BID_ >> 3, spx_ = GDIM_ >> 3, SM_ = 64 / (SN), nsn_ = (NT) / (SN), nst_ = (((MT) + SM_ - 1) / SM_) * nsn_; \
    for (int s_ = xcd_; s_ < nst_; s_ += 8) for (int sl_ = slot_; sl_ < 64; sl_ += spx_)
#define TILE_MT(SN) ((s_ / nsn_) * SM_ + sl_ / (SN))
#define TILE_NT(SN) ((s_ % nsn_) * (SN) + sl_ % (SN))
DI void phase_gemm_z(const Params& p, char* smem8) {
    const bf16_t* H = (const bf16_t*)(p.ws + OFF_H); const bf16_t* W = (const bf16_t*)(p.ws + OFF_W) + WO_IN; bf16_t* Z = (bf16_t*)(p.ws + OFF_Z);
    for (int tile = PBID_; tile < 66 * 6; tile += PGDIM_) {
        const int row0 = (tile / 6) * 256, col0 = (tile % 6) * 256;
        f32x4 acc[8][4];
        gemm_main3(acc, H, LD1, R, W, LD1, 1440, 1024, row0, col0, smem8);
        stage_tile8(acc, smem8, Z, 1440, row0, col0, 1440);
    }
}
DI void phase_gemm_qkv(const Params& p, char* smem) {
    const bf16_t* QIN = (const bf16_t*)(p.ws + OFF_T + T_QIN); const bf16_t* CKV = (const bf16_t*)(p.ws + OFF_T + T_CKV);
    const bf16_t* W = (const bf16_t*)(p.ws + OFF_W);
    bf16_t* Qb = (bf16_t*)(p.ws + OFF_Q); bf16_t* Kb = (bf16_t*)(p.ws + OFF_K); bf16_t* Vt = (bf16_t*)(p.ws + OFF_VT);
    const float* rc = (const float*)(p.ws + OFF_ROPE); const float* rs = rc + 8192 * 16;
    const float qscale = 0.10206207261596577f * 1.4426950408889634f;
    for (int tile = BID_; tile < 792 + 528 + 528; tile += GDIM_) {
        f32x4 acc[4][4];
        if (tile < 792) {
            const int row0 = (tile / 6) * 128, col0 = (tile % 6) * 128;
            gemm_main(acc, QIN, 384, R, W + WO_UQ, 384, 768, 384, row0, col0, smem);
            EPI_VARS
            const int gn0 = (col0 + wn_ * 64) >> 4;
#pragma unroll
            for (int mi = 0; mi < 4; ++mi) {
                const int row = EPI_ROW(mi), t = row % TPB;
#pragma unroll
                for (int ni = 0; ni < 3; ++ni) {
                    if ((gn0 + ni) % 6 == 4 && t >= CTX) {
                        const f32x4 c = *(const f32x4*)(rc + (size_t)(t - CTX) * 16 + quad_ * 4), s = *(const f32x4*)(rs + (size_t)(t - CTX) * 16 + quad_ * 4);
                        const f32x4 x1 = acc[mi][ni], x2 = acc[mi][ni + 1];
                        acc[mi][ni] = x1 * c - x2 * s; acc[mi][ni + 1] = x2 * c + x1 * s;
                    }
                }
#pragma unroll
                for (int ni = 0; ni < 4; ++ni) acc[mi][ni] *= qscale;
            }
            stage_tile_bf16<4>(acc, smem, Qb, 768, row0, col0, 768);
        } else if (tile < 792 + 528) {
            const int tt = tile - 792, row0 = (tt / 4) * 128, col0 = (tt % 4) * 128;
            gemm_main(acc, CKV, 256, R, W + WO_K, 256, 512, 256, row0, col0, smem);
            EPI_VARS
            stage_tile_bf16<4>(acc, smem, Kb, 768, row0, col0, 512, true);
        } else {
            const int tt = tile - 792 - 528, row0 = (tt & 3) * 128, col0 = (tt >> 2) * 128;
            gemm_main(acc, W + WO_V, 256, 512, CKV, 256, R, 256, row0, col0, smem);
            EPI_VARS
            { const int b_ = col0 / TPB, t0_ = col0 - b_ * TPB;
              stage_tile_bf16<4>(acc, smem, Vt + (size_t)(b_ * 512) * TPB + t0_, TPB, row0, 0, 128); }
        }
    }
}
DI void phase_gemm_glu(const Params& p, int l, char* smem) {
    const bf16_t* YG = (const bf16_t*)(p.ws + OFF_T + T_YG); const bf16_t* W = (const bf16_t*)(p.ws + OFF_W) + WO_GLU; bf16_t* OS = (bf16_t*)(p.ws + OFF_OS);
    const float* bg = p.in[22] + l * 384;
    for (int tile = BID_; tile < 132 * 3; tile += GDIM_) {
        const int row0 = (tile / 3) * 128, col0 = (tile % 3) * 128;
        f32x4 acc[4][4];
        gemm_main(acc, YG, 384, R, W, 384, 384, 384, row0, col0, smem);
        EPI_VARS
#pragma unroll
        for (int mi = 0; mi < 4; ++mi)
#pragma unroll
            for (int ni = 0; ni < 4; ++ni) {
                const int row = EPI_ROW(mi), col = EPI_COL(ni);
                const uint2 yw = *(const uint2*)(YG + (size_t)row * 384 + col);
                const f32x4 b = *(const f32x4*)(bg + col);
                const float y0 = bflo(yw.x), y1 = bfhi(yw.x), y2 = bflo(yw.y), y3 = bfhi(yw.y);
                st_bf4(OS + (size_t)row * 384 + col, y0 * sigmoidf_(acc[mi][ni][0] + b[0]), y1 * sigmoidf_(acc[mi][ni][1] + b[1]),
                       y2 * sigmoidf_(acc[mi][ni][2] + b[2]), y3 * sigmoidf_(acc[mi][ni][3] + b[3]));
            }
    }
}
DI void phase_merge(const Params& p, int l, char* smem, char* smem8) {
    const bf16_t* H = (const bf16_t*)(p.ws + OFF_H); const bf16_t* W = (const bf16_t*)(p.ws + OFF_W);
    const bf16_t* OA = (const bf16_t*)(p.ws + OFF_OA); const bf16_t* OFb = (const bf16_t*)(p.ws + OFF_OF); const bf16_t* OS = (const bf16_t*)(p.ws + OFF_OS);
    bf16_t* M = (bf16_t*)(p.ws + OFF_Z);
    const float* bgate = p.in[27] + l * 3072;
    for (int tile = PBID_; tile < 256; tile += PGDIM_) {
        const int rt = tile >> 2, row0 = ((rt >> 5) * 33 + 1 + (rt & 31)) * 256, col0 = (tile & 3) * 256;
#pragma unroll 1
        for (int br = 0; br < 3; ++br) {
            f32x4 acc[8][4];
            gemm_main3(acc, H, LD1, R, W + WO_GATE + (size_t)br * 1024 * LD1, LD1, 1024, 1024, row0, col0, smem8);
            {
                EPI8_VARS
                unsigned* gs = (unsigned*)(p.ws + OFF_Q) + ((size_t)tile * 2 * 64 * 512) + tid8_;
                const float* bg = bgate + br * 1024 + col0 + wc_ * 64 + quade_ * 4;
#pragma unroll
                for (int mi = 0; mi < 8; ++mi) {
                    __builtin_amdgcn_sched_barrier(0);
#pragma unroll
                    for (int ni = 0; ni < 4; ++ni) {
                        const f32x4 bb = *(const f32x4*)(bg + ni * 16);
                        gs[((mi * 4 + ni) * 2 + 0) * 512] = pack2(sigmoidf_(acc[mi][ni][0] + bb[0]), sigmoidf_(acc[mi][ni][1] + bb[1]));
                        gs[((mi * 4 + ni) * 2 + 1) * 512] = pack2(sigmoidf_(acc[mi][ni][2] + bb[2]), sigmoidf_(acc[mi][ni][3] + bb[3]));
                    }
                }
            }
            const bf16_t* Ab = br == 0 ? OA : (br == 1 ? OFb : OS);
            const int Kb = br == 0 ? 512 : 384;
            const bf16_t* Wb = W + (br == 0 ? WO_BA : (br == 1 ? WO_BF : WO_BS));
            gemm_main3(acc, Ab, Kb, R, Wb, Kb, 1024, Kb, row0, col0, smem8);
            {
                EPI8_VARS
                unsigned* gs = (unsigned*)(p.ws + OFF_Q) + ((size_t)tile * 2 * 64 * 512) + tid8_;
                unsigned* ts = gs + 64 * 512;
#pragma unroll
                for (int mi = 0; mi < 8; ++mi) {
                    __builtin_amdgcn_sched_barrier(0);
#pragma unroll
                    for (int ni = 0; ni < 4; ++ni) {
                        const unsigned g0 = gs[((mi * 4 + ni) * 2 + 0) * 512], g1 = gs[((mi * 4 + ni) * 2 + 1) * 512];
                        f32x4 t = {0.f, 0.f, 0.f, 0.f};
                        if (br > 0) { const unsigned t0 = ts[((mi * 4 + ni) * 2 + 0) * 512], t1 = ts[((mi * 4 + ni) * 2 + 1) * 512]; t = (f32x4){bflo(t0), bfhi(t0), bflo(t1), bfhi(t1)}; }
                        t[0] += bflo(g0) * acc[mi][ni][0]; t[1] += bfhi(g0) * acc[mi][ni][1]; t[2] += bflo(g1) * acc[mi][ni][2]; t[3] += bfhi(g1) * acc[mi][ni][3];
                        if (br < 2) { ts[((mi * 4 + ni) * 2 + 0) * 512] = pack2(t[0], t[1]); ts[((mi * 4 + ni) * 2 + 1) * 512] = pack2(t[2], t[3]); }
                        acc[mi][ni] = t;
                    }
                }
            }
            if (br == 2) stage_tile8(acc, smem8, M, LD1, row0, col0, 1024);
        }
    }
    const int nctx = (l == 0 ? 32 : 0);
    for (int tile = BID_; tile < nctx; tile += GDIM_) {
        const int ct = tile >> 3, row0 = (ct >> 1) * TPB + (ct & 1) * 128, col0 = (tile & 7) * 128;
        const size_t sbase = (size_t)256 * 2 * 64 * 512 + (size_t)tile * 32 * 256;
#pragma unroll 1
        for (int br = 0; br < 3; ++br) {
            {
                f32x4 acc[4][4];
                gemm_main(acc, H, LD1, R, W + WO_GATE + (size_t)br * 1024 * LD1, LD1, 1024, 1024, row0, col0, smem);
                EPI_VARS
                unsigned* gs = (unsigned*)(p.ws + OFF_Q) + sbase + tid_;
#pragma unroll
                for (int mi = 0; mi < 4; ++mi)
#pragma unroll
                    for (int ni = 0; ni < 4; ++ni) {
                        const f32x4 b = *(const f32x4*)(bgate + br * 1024 + EPI_COL(ni));
                        gs[((mi * 4 + ni) * 2 + 0) * 256] = pack2(sigmoidf_(acc[mi][ni][0] + b[0]), sigmoidf_(acc[mi][ni][1] + b[1]));
                        gs[((mi * 4 + ni) * 2 + 1) * 256] = pack2(sigmoidf_(acc[mi][ni][2] + b[2]), sigmoidf_(acc[mi][ni][3] + b[3]));
                    }
            }
            f32x4 acc[4][4];
            const bf16_t* Ab = br == 0 ? OA : (br == 1 ? OFb : OS);
            const int Kb = br == 0 ? 512 : 384;
            const bf16_t* Wb = W + (br == 0 ? WO_BA : (br == 1 ? WO_BF : WO_BS));
            gemm_main(acc, Ab, Kb, R, Wb, Kb, 1024, Kb, row0, col0, smem);
            EPI_VARS
            const unsigned* gs = (const unsigned*)(p.ws + OFF_Q) + sbase + tid_;
#pragma unroll
            for (int mi = 0; mi < 4; ++mi)
#pragma unroll
                for (int ni = 0; ni < 4; ++ni) {
                    const unsigned g0 = gs[((mi * 4 + ni) * 2 + 0) * 256], g1 = gs[((mi * 4 + ni) * 2 + 1) * 256];
                    uint2* mp = (uint2*)(M + (size_t)EPI_ROW(mi) * LD1 + EPI_COL(ni));
                    uint2 t = make_uint2(0u, 0u);
                    if (br > 0) t = *mp;
                    t.x = pack2(bflo(t.x) + bflo(g0) * acc[mi][ni][0], bfhi(t.x) + bfhi(g0) * acc[mi][ni][1]);
                    t.y = pack2(bflo(t.y) + bflo(g1) * acc[mi][ni][2], bfhi(t.y) + bfhi(g1) * acc[mi][ni][3]);
                    *mp = t;
                }
        }
    }
}
DI void phase_gemm_res(const Params& p, int l, int which, char* smem, char* smem8) {
    const bf16_t* A = (const bf16_t*)(p.ws + OFF_Z); const bf16_t* W = (const bf16_t*)(p.ws + OFF_W) + (which == 0 ? WO_OUT : WO_2);
    const int K = which == 0 ? 1024 : 4096, LDK = which == 0 ? LD1 : LD4;
    const bool orig = (which == 0 && l == 0);
    const int goff = which == 0 ? 2048 : 5120;
    {
        for (int tile = PBID_; tile < 256; tile += PGDIM_) {
            const int rt = tile >> 2, row0 = ((rt >> 5) * 33 + 1 + (rt & 31)) * 256, col0 = (tile & 3) * 256;
            f32x4 acc[8][4];
            gemm_main3(acc, A, LDK, R, W, LDK, 1024, K, row0, col0, smem8);
            EPI8_VARS
            const int b_ = rt >> 5;
            const size_t lat0 = (size_t)(b_ * SEQ + (rt & 31) * 256) * 1024;
            const float* xin = (orig ? p.in[0] : p.out) + lat0; float* xout = p.out + lat0;
            const float* gate = (const float*)(p.ws + OFF_MOD) + (size_t)(l * 3 + b_) * 6144 + goff;
#pragma unroll
            for (int mi = 0; mi < 8; ++mi) {
                __builtin_amdgcn_sched_barrier(0);
                const size_t ro = (size_t)(wr_ * 128 + mi * 16 + l15e_) * 1024;
#pragma unroll
                for (int ni = 0; ni < 4; ++ni) {
                    const int col = EPI8_COL(ni);
                    const f32x4 x = *(const f32x4*)(xin + ro + col), g = *(const f32x4*)(gate + col);
                    *(f32x4*)(xout + ro + col) = x + g * acc[mi][ni];
                }
            }
        }
    }
    const int ksh = which == 0 ? 2 : 3, KS = 1 << ksh, Kc = K >> ksh;
    const int nitems = (l == 0 ? 32 << ksh : 0);
    for (int item = BID_; item < nitems; item += GDIM_) {
        const int tt = item >> ksh, kp = item & (KS - 1), ct = tt >> 3, row0 = (ct >> 1) * TPB + (ct & 1) * 128, col0 = (tt & 7) * 128;
        f32x4 acc[4][4];
        gemm_main(acc, A + kp * Kc, LDK, R, W + kp * Kc, LDK, 1024, Kc, row0, col0, smem);
        EPI_VARS
        float* xcb = (float*)(p.ws + OFF_XC) + (size_t)((ct >> 1) * CTX + (ct & 1) * 128) * 1024;
        const float* gate = (const float*)(p.ws + OFF_MOD) + (size_t)(l * 3 + 2) * 6144 + goff;
#pragma unroll
        for (int mi = 0; mi < 4; ++mi) {
            __builtin_amdgcn_sched_barrier(0);
            float* xo = xcb + (size_t)(wm_ * 64 + mi * 16 + l15_) * 1024;
#pragma unroll
            for (int ni = 0; ni < 4; ++ni) {
                const int col = EPI_COL(ni);
                const f32x4 g = *(const f32x4*)(gate + col);
#pragma unroll
                for (int j = 0; j < 4; ++j) unsafeAtomicAdd(xo + col + j, g[j] * acc[mi][ni][j]);
            }
        }
    }
}
DI void phase_mlp1(const Params& p, int l, char* smem, char* smem8) {
    const bf16_t* H = (const bf16_t*)(p.ws + OFF_H); const bf16_t* W = (const bf16_t*)(p.ws + OFF_W) + WO_1; bf16_t* U = (bf16_t*)(p.ws + OFF_Z);
    for (int tile = PBID_; tile < 1024; tile += PGDIM_) {
        const int rt = tile >> 4, row0 = ((rt >> 5) * 33 + 1 + (rt & 31)) * 256, col0 = (tile & 15) * 256;
        f32x4 acc[8][4];
        gemm_main3(acc, H, LD1, R, W, LD1, 4096, 1024, row0, col0, smem8);
#pragma unroll
        for (int mi = 0; mi < 8; ++mi)
#pragma unroll
            for (int ni = 0; ni < 4; ++ni)
#pragma unroll
                for (int j = 0; j < 4; ++j) { const float r = fmaxf(acc[mi][ni][j], 0.f); acc[mi][ni][j] = r * r; }
        stage_tile8(acc, smem8, U, LD4, row0, col0, 4096);
    }
    const int ntiles = (l == 0 ? 128 : 0);
    for (int tile = BID_; tile < ntiles; tile += GDIM_) {
        const int ct = tile >> 5, row0 = (ct >> 1) * TPB + (ct & 1) * 128, col0 = (tile & 31) * 128;
        f32x4 acc[4][4];
        gemm_main(acc, H, LD1, R, W, LD1, 4096, 1024, row0, col0, smem);
#pragma unroll
        for (int mi = 0; mi < 4; ++mi)
#pragma unroll
            for (int ni = 0; ni < 4; ++ni)
#pragma unroll
                for (int j = 0; j < 4; ++j) { const float r = fmaxf(acc[mi][ni][j], 0.f); acc[mi][ni][j] = r * r; }
        stage_tile_bf16<4>(acc, smem, U, LD4, row0, col0, 4096);
    }
}

DI void attn_item(const Params& p, int b, int h, int qrow0, int nkeys, char* smem) {
    const int tid = TID_, lane = tid & 63, wave = tid >> 6, l15 = lane & 15, quad = lane >> 4;
    const bf16_t* Qb = (const bf16_t*)(p.ws + OFF_Q); const bf16_t* Kb = (const bf16_t*)(p.ws + OFF_K); const bf16_t* Vt = (const bf16_t*)(p.ws + OFF_VT);
    bf16_t* OA = (bf16_t*)(p.ws + OFF_OA);
    char* Ks = smem;
    bf16_t* Vs = (bf16_t*)(smem + 2 * 12288);
    bf16x8 qf[4][3];
#pragma unroll
    for (int qt = 0; qt < 4; ++qt)
#pragma unroll
        for (int s = 0; s < 3; ++s) qf[qt][s] = *(const bf16x8*)(Qb + (size_t)(qrow0 + wave * 64 + qt * 16 + l15) * 768 + h * 96 + s * 32 + quad * 8);
    f32x4 o[4][4];
#pragma unroll
    for (int i = 0; i < 4; ++i)
#pragma unroll
        for (int j = 0; j < 4; ++j) o[i][j] = (f32x4){0.f, 0.f, 0.f, 0.f};
    float m[4] = {0.f, 0.f, 0.f, 0.f}, lsum[4] = {0.f, 0.f, 0.f, 0.f};
    bool first = true;
    int kp[3], vp[2];
    const bf16_t* kbase = Kb + ((size_t)b * TPB) * 768 + h * 96; const bf16_t* vbase = Vt + (size_t)(b * 8 + h) * 64 * TPB;
    const int sb_ = lane * 16, swz_ = sb_ ^ (((sb_ >> 9) & 1) << 5), sr_ = swz_ >> 6, sk_ = (swz_ & 63) >> 1;
    const int lo = (l15 * 64 + quad * 16) ^ ((l15 >> 3) << 5);
#pragma unroll
    for (int i = 0; i < 3; ++i) { const int st = wave + 4 * i, key = (st / 3) * 16 + sr_, dim = (st % 3) * 32 + sk_; kp[i] = key * 768 + dim; }
#pragma unroll
    for (int i = 0; i < 2; ++i) { const int d = (wave * 2 + i) * 8 + (lane >> 3), c = (lane & 7) ^ ((d >> 1) & 7); vp[i] = d * TPB + c * 8; }
    const int kofs = wave * 1024 + lane * 16;
    const int vofs = wave * 2048 + lane * 16;
    u32x4 kr[3], vr[2];
#pragma unroll
    for (int i = 0; i < 3; ++i) kr[i] = *(const u32x4*)(kbase + kp[i]);
#pragma unroll
    for (int i = 0; i < 2; ++i) vr[i] = *(const u32x4*)(vbase + vp[i]);
#pragma unroll
    for (int i = 0; i < 3; ++i) *(u32x4*)(Ks + i * 4096 + kofs) = kr[i];
#pragma unroll
    for (int i = 0; i < 2; ++i) *(u32x4*)((char*)Vs + i * 1024 + vofs) = vr[i];
    __syncthreads();
    const int NT = nkeys >> 6;
    for (int it = 0; it < NT; ++it) {
        const int buf = it & 1;
        if (it + 1 < NT) {
#pragma unroll
            for (int i = 0; i < 3; ++i) kr[i] = *(const u32x4*)(kbase + (size_t)(it + 1) * 64 * 768 + kp[i]);
#pragma unroll
            for (int i = 0; i < 2; ++i) vr[i] = *(const u32x4*)(vbase + (it + 1) * 64 + vp[i]);
        }
#pragma unroll
        for (int hk = 0; hk < 2; ++hk) {
            f32x4 s[2][4];
#pragma unroll
            for (int k2 = 0; k2 < 2; ++k2) {
#pragma unroll
                for (int qt = 0; qt < 4; ++qt) { const float nm = -m[qt]; s[k2][qt] = (f32x4){nm, nm, nm, nm}; }
#pragma unroll
                for (int ss = 0; ss < 3; ++ss) {
                    const bf16x8 kf = *(const bf16x8*)(Ks + buf * 12288 + ((hk * 2 + k2) * 3 + ss) * 1024 + lo);
#pragma unroll
                    for (int qt = 0; qt < 4; ++qt) s[k2][qt] = MFMA16(kf, qf[qt][ss], s[k2][qt]);
                }
            }
            bf16x8 pf[4];
#pragma unroll
            for (int qt = 0; qt < 4; ++qt) {
                float mx = max3f(s[0][qt][0], s[0][qt][1], s[0][qt][2]);
                mx = max3f(mx, s[0][qt][3], s[1][qt][0]);
                mx = max3f(mx, s[1][qt][1], s[1][qt][2]);
                mx = fmaxf(mx, s[1][qt][3]);
                if (__builtin_amdgcn_ballot_w64(mx > 8.f || first) != 0) {
                    mx = fmaxf(mx, shx(mx, 16)); mx = fmaxf(mx, shx(mx, 32));
                    const float d = first ? mx : fmaxf(mx, 0.f);
                    const float alpha = __builtin_amdgcn_exp2f(-d);
                    m[qt] += d; lsum[qt] *= alpha;
#pragma unroll
                    for (int dt = 0; dt < 4; ++dt) o[dt][qt] *= alpha;
#pragma unroll
                    for (int k2 = 0; k2 < 2; ++k2)
#pragma unroll
                        for (int j = 0; j < 4; ++j) s[k2][qt][j] -= d;
                }
                float rsum = 0.f;
#pragma unroll
                for (int k2 = 0; k2 < 2; ++k2)
#pragma unroll
                    for (int j = 0; j < 4; ++j) { const float pv = __builtin_amdgcn_exp2f(s[k2][qt][j]); s[k2][qt][j] = pv; rsum += pv; }
                lsum[qt] += rsum;
                u32x4 w;
                w.x = pack2(s[0][qt][0], s[0][qt][1]); w.y = pack2(s[0][qt][2], s[0][qt][3]);
                w.z = pack2(s[1][qt][0], s[1][qt][1]); w.w = pack2(s[1][qt][2], s[1][qt][3]);
                pf[qt] = __builtin_bit_cast(bf16x8, w);
            }
            first = false;
#pragma unroll
            for (int dt = 0; dt < 4; ++dt) {
                const int d_ = dt * 16 + l15, sw_ = (d_ >> 1) & 7, c0_ = hk * 4 + (quad >> 1);
                const char* vb_ = (const char*)Vs + buf * 8192 + d_ * 128 + (quad & 1) * 8;
                const uint2 lo2 = *(const uint2*)(vb_ + ((c0_ ^ sw_) << 4)), hi2 = *(const uint2*)(vb_ + (((c0_ + 2) ^ sw_) << 4));
                u32x4 w; w.x = lo2.x; w.y = lo2.y; w.z = hi2.x; w.w = hi2.y;
                const bf16x8 vf = __builtin_bit_cast(bf16x8, w);
#pragma unroll
                for (int qt = 0; qt < 4; ++qt) o[dt][qt] = MFMA16(vf, pf[qt], o[dt][qt]);
            }
        }
        if (it + 1 < NT) {
#pragma unroll
            for (int i = 0; i < 3; ++i) *(u32x4*)(Ks + (buf ^ 1) * 12288 + i * 4096 + kofs) = kr[i];
#pragma unroll
            for (int i = 0; i < 2; ++i) *(u32x4*)((char*)Vs + (buf ^ 1) * 8192 + i * 1024 + vofs) = vr[i];
        }
        __syncthreads();
    }
#pragma unroll
    for (int qt = 0; qt < 4; ++qt) {
        float ls = lsum[qt]; ls += shx(ls, 16); ls += shx(ls, 32);
        const float inv = 1.f / ls;
        const int row = qrow0 + wave * 64 + qt * 16 + l15;
#pragma unroll
        for (int dt = 0; dt < 4; ++dt)
            st_bf4(OA + (size_t)row * 512 + h * 64 + dt * 16 + quad * 4, o[dt][qt][0] * inv, o[dt][qt][1] * inv, o[dt][qt][2] * inv, o[dt][qt][3] * inv);
    }
}
DI void phase_attn(const Params& p, int l, char* smem) {
    if (PGDIM_ == 256) {
        const int pb = PBID_, x = pb & 7, local = (pb >> 3) * 2 + HALF_;
        const int pr = x + 8 * (local >> 5), qb = local & 31, b = pr >> 3, h = pr & 7;
        attn_item(p, b, h, b * TPB + CTX + qb * 256, TPB, smem);
    } else {
        for (int item = BID_; item < 512; item += GDIM_) { const int qb = item & 31, h = (item >> 5) & 7, b = item >> 8; attn_item(p, b, h, b * TPB + CTX + qb * 256, TPB, smem); }
    }
    if (l == 0)
        for (int it = BID_; it < 16; it += GDIM_) { const int h = it & 7, b = it >> 3; attn_item(p, b, h, b * TPB, CTX, smem); }
}

template <int N1, int N2>
DI void four1_item(const Params& p, int b, int n2, int g, int tok0, const bf16_t* __restrict__ T1, const float* __restrict__ TW, bf16_t* __restrict__ F1, char* smem) {
    const int tid = TID_, lane = tid & 63, wave = tid >> 6, l15 = lane & 15, quad = lane >> 4;
    constexpr int XS = 2 * N1 + 8;
    const bf16_t* Z = (const bf16_t*)(p.ws + OFF_Z); const bf16_t* T0 = (const bf16_t*)(p.ws + OFF_T0);
    bf16_t* Ua = (bf16_t*)smem;
    bf16_t* Xt = Ua + N1 * 72;
    for (int c = tid; c < N1 * 8; c += 256) {
        const int n1 = c >> 3, part = c & 7;
        *(uint4*)&Ua[n1 * 72 + part * 8] = *(const uint4*)(Z + (size_t)(tok0 + N2 * n1 + n2) * 1440 + 672 + g * 64 + part * 8);
    }
    __syncthreads();
    for (int mt = wave; mt < 8; mt += 4) {
        const bf16x8 a0 = *(const bf16x8*)(T0 + (mt * 16 + l15) * 64 + quad * 8);
        const bf16x8 a1 = *(const bf16x8*)(T0 + (mt * 16 + l15) * 64 + 32 + quad * 8);
#pragma unroll
        for (int nt = 0; nt < N1 / 16; ++nt) {
            f32x4 acc = {0.f, 0.f, 0.f, 0.f};
            acc = MFMA16(a0, *(const bf16x8*)&Ua[(nt * 16 + l15) * 72 + quad * 8], acc);
            acc = MFMA16(a1, *(const bf16x8*)&Ua[(nt * 16 + l15) * 72 + 32 + quad * 8], acc);
            const int kp0 = mt * 8 + quad * 2, n1 = nt * 16 + l15;
            *(unsigned*)&Xt[kp0 * XS + 2 * n1] = pack2(acc[0], acc[1]);
            *(unsigned*)&Xt[(kp0 + 1) * XS + 2 * n1] = pack2(acc[2], acc[3]);
        }
    }
    __syncthreads();
    for (int mt = wave; mt < 2 * N1 / 16; mt += 4) {
        constexpr int KS1 = 2 * N1 / 32;
        bf16x8 af[KS1];
#pragma unroll
        for (int ks = 0; ks < KS1; ++ks) af[ks] = *(const bf16x8*)(T1 + (mt * 16 + l15) * (2 * N1) + ks * 32 + quad * 8);
#pragma unroll
        for (int nt = 0; nt < 4; ++nt) {
            f32x4 acc = {0.f, 0.f, 0.f, 0.f};
#pragma unroll
            for (int ks = 0; ks < KS1; ++ks) {
                const bf16x8 bb = *(const bf16x8*)&Xt[(nt * 16 + l15) * XS + ks * 32 + quad * 8];
                acc = MFMA16(af[ks], bb, acc);
            }
            const int k1a = mt * 8 + quad * 2, kp = nt * 16 + l15;
#pragma unroll
            for (int hf = 0; hf < 2; ++hf) {
                const int k1 = k1a + hf; const float orr = acc[2 * hf], oi = acc[2 * hf + 1];
                const float c = TW[2 * (n2 * k1)], s = TW[2 * (n2 * k1) + 1];
                *(unsigned*)&F1[(((size_t)b * N1 + k1) * N2 + n2) * 768 + (g * 64 + kp) * 2] = pack2(orr * c + oi * s, oi * c - orr * s);
            }
        }
    }
    __syncthreads();
}
template <int N1, int N2>
DI void four2_item(const Params& p, int b, int k1, int g, int tok0, const bf16_t* __restrict__ T2, const bf16_t* __restrict__ F1, char* smem) {
    const int tid = TID_, lane = tid & 63, wave = tid >> 6, l15 = lane & 15, quad = lane >> 4;
    constexpr int DS = 2 * N2 + 8;
    bf16_t* OFb = (bf16_t*)(p.ws + OFF_OF);
    bf16_t* Dt = (bf16_t*)smem;
    for (int c = tid; c < N2 * 16; c += 256) {
        const int n2 = c >> 4, part = c & 15;
        const uint4 v = *(const uint4*)(F1 + (((size_t)b * N1 + k1) * N2 + n2) * 768 + g * 128 + part * 8);
        *(unsigned*)&Dt[(part * 4 + 0) * DS + 2 * n2] = v.x; *(unsigned*)&Dt[(part * 4 + 1) * DS + 2 * n2] = v.y;
        *(unsigned*)&Dt[(part * 4 + 2) * DS + 2 * n2] = v.z; *(unsigned*)&Dt[(part * 4 + 3) * DS + 2 * n2] = v.w;
    }
    __syncthreads();
    constexpr float scale = (N1 * N2 == 8192) ? 0.0013810679320049757f : 0.0078125f;
    {
        constexpr int NTT = N2 / 16, KS2 = 2 * N2 / 32;
        const int nt = NTT == 4 ? wave : 0;
        bf16x8 bt[KS2];
#pragma unroll
        for (int ks = 0; ks < KS2; ++ks) bt[ks] = *(const bf16x8*)(T2 + (nt * 16 + l15) * (2 * N2) + ks * 32 + quad * 8);
#pragma unroll
        for (int mi = 0; mi < (NTT == 4 ? 4 : 1); ++mi) {
            const int mt = NTT == 4 ? mi : wave;
            f32x4 acc = {0.f, 0.f, 0.f, 0.f};
#pragma unroll
            for (int ks = 0; ks < KS2; ++ks) {
                const bf16x8 a = *(const bf16x8*)&Dt[(mt * 16 + l15) * DS + ks * 32 + quad * 8];
                acc = MFMA16(a, bt[ks], acc);
            }
            const int k2 = nt * 16 + l15, row = tok0 + k1 + N1 * k2;
            st_bf4(OFb + (size_t)row * 384 + g * 64 + mt * 16 + quad * 4, acc[0] * scale, acc[1] * scale, acc[2] * scale, acc[3] * scale);
        }
    }
    __syncthreads();
}
DI void phase_four1(const Params& p, int l, char* smem) {
    const int nitems = 768 + (l == 0 ? 192 : 0);
    bf16_t* F1L = (bf16_t*)(p.ws + OFF_T + T_F1L); bf16_t* F1C = (bf16_t*)(p.ws + OFF_T + T_F1C);
    for (int item = BID_; item < nitems; item += GDIM_) {
        if (item < 768) { const int g = item % 6, n2 = (item / 6) & 63, b = item / 384;
            four1_item<128, 64>(p, b, n2, g, b * TPB + CTX, (const bf16_t*)(p.ws + OFF_T1L), (const float*)(p.ws + OFF_TW8192), F1L, smem); }
        else { const int it = item - 768, g = it % 6, n2 = (it / 6) & 15, b = it / 96;
            four1_item<16, 16>(p, b, n2, g, b * TPB, (const bf16_t*)(p.ws + OFF_T1C), (const float*)(p.ws + OFF_TW256), F1C, smem); }
    }
}
DI void phase_four2(const Params& p, int l, char* smem) {
    const int nitems = 1536 + (l == 0 ? 192 : 0);
    const bf16_t* F1L = (const bf16_t*)(p.ws + OFF_T + T_F1L); const bf16_t* F1C = (const bf16_t*)(p.ws + OFF_T + T_F1C);
    for (int item = BID_; item < nitems; item += GDIM_) {
        if (item < 1536) { const int g = item % 6, k1 = (item / 6) & 127, b = item / 768;
            four2_item<128, 64>(p, b, k1, g, b * TPB + CTX, (const bf16_t*)(p.ws + OFF_T2L), F1L, smem); }
        else { const int it = item - 1536, g = it % 6, k1 = (it / 6) & 15, b = it / 96;
            four2_item<16, 16>(p, b, k1, g, b * TPB, (const bf16_t*)(p.ws + OFF_T2C), F1C, smem); }
    }
}

#define WAVE_SYNC { __builtin_amdgcn_fence(__ATOMIC_RELEASE, "wavefront"); __builtin_amdgcn_wave_barrier(); __builtin_amdgcn_fence(__ATOMIC_ACQUIRE, "wavefront"); }
DI int ssm_tok(int dir, int sidx) { return dir == 0 ? sidx : (sidx < CTX ? CTX - 1 - sidx : (TPB + CTX - 1) - sidx); }
DI void ssm_load_bbf(const Params& p, int dg, int lane, bf16x8 (&bbf)[8]) {
    const bf16_t* bbt = (const bf16_t*)(p.ws + OFF_BBAR) + (size_t)dg * 128 * 16;
    const int l15 = lane & 15, quad = lane >> 4;
#pragma unroll
    for (int mt = 0; mt < 8; ++mt) {
        bf16x8 v = {0, 0, 0, 0, 0, 0, 0, 0};
        if (quad < 2) v = *(const bf16x8*)(bbt + (mt * 16 + l15) * 16 + quad * 8);
        bbf[mt] = v;
    }
}
template <bool REV, bool STORE>
DI void ssm_sub(const bf16_t* __restrict__ Z, int row0, int g, const bf16x8 (&bbf)[8], float ar, float ai, float& sr, float& si, float* BUs, unsigned* Sw, int lane) {
    const int l15 = lane & 15, quad = lane >> 4;
    bf16x8 uf = {0, 0, 0, 0, 0, 0, 0, 0};
    if (quad < 2) uf = *(const bf16x8*)(Z + (size_t)(row0 + l15) * 1440 + 1056 + g * 16 + quad * 8);
#pragma unroll
    for (int mt = 0; mt < 8; ++mt) {
        const f32x4 d = MFMA16(bbf[mt], uf, ((f32x4){0.f, 0.f, 0.f, 0.f}));
        *(f32x4*)&BUs[l15 * 132 + mt * 16 + quad * 4] = d;
    }
    WAVE_SYNC
#pragma unroll
    for (int i = 0; i < 16; ++i) {
        const int tt = REV ? 15 - i : i;
        const f2_t bq = *(const f2_t*)&BUs[tt * 132 + 2 * lane];
        const float nr = ar * sr - ai * si + bq[0], ni = ar * si + ai * sr + bq[1];
        sr = nr; si = ni;
        if (STORE) Sw[tt * 68 + lane] = pack2(sr, si);
    }
    WAVE_SYNC
}
DI void phase_ssm1(const Params& p, char* smem) {
    const int lane = TID_ & 63, wave = TID_ >> 6, gw = BID_ * 4 + wave, nw = GDIM_ * 4;
    const bf16_t* Z = (const bf16_t*)(p.ws + OFF_Z); float* SEND = (float*)(p.ws + OFF_OS + T_SEND);
    float* BUs = (float*)smem + wave * (16 * 132);
    for (int item = gw; item < 2 * 2 * 24 * 132; item += nw) {
        const int g = item % 24, q = (item / 24) % 132, dir = (item / (24 * 132)) & 1, b = item / (24 * 132 * 2);
        bf16x8 bbf[8]; ssm_load_bbf(p, dir * 24 + g, lane, bbf);
        const float* abar = (const float*)(p.ws + OFF_ABAR) + (size_t)((dir * 24 + g) * 64 + lane) * 2;
        const float ar = abar[0], ai = abar[1];
        float sr = 0.f, si = 0.f;
        for (int sb = 0; sb < 4; ++sb) {
            if (dir == 0) ssm_sub<false, false>(Z, b * TPB + q * 64 + sb * 16, g, bbf, ar, ai, sr, si, BUs, nullptr, lane);
            else ssm_sub<true, false>(Z, b * TPB + ssm_tok(1, q * 64 + sb * 16 + 15), g, bbf, ar, ai, sr, si, BUs, nullptr, lane);
        }
        float* dst = SEND + ((size_t)(((b * 2 + dir) * 24 + g) * 132 + q) * 64 + lane) * 2;
        dst[0] = sr; dst[1] = si;
    }
}
DI void phase_ssm2(const Params& p) {
    const int lane = TID_ & 63, gw = BID_ * 4 + (TID_ >> 6), nw = GDIM_ * 4;
    const float* SEND = (const float*)(p.ws + OFF_OS + T_SEND); float* CARRY = (float*)(p.ws + OFF_OS + T_CARRY);
    for (int item = gw; item < 96; item += nw) {
        const int dg = item % 48;
        const float* a64 = (const float*)(p.ws + OFF_A64) + (size_t)(dg * 64 + lane) * 2;
        const float ar = a64[0], ai = a64[1];
        float sr = 0.f, si = 0.f;
        const size_t base = (size_t)item * 132;
#pragma unroll 12
        for (int q = 0; q < 132; ++q) {
            const size_t o = ((base + q) * 64 + lane) * 2;
            const float er = SEND[o], ei = SEND[o + 1];
            CARRY[o] = sr; CARRY[o + 1] = si;
            const float nr = ar * sr - ai * si + er, ni = ar * si + ai * sr + ei;
            sr = nr; si = ni;
        }
    }
}
template <int DIR>
DI void ssm3_dir(const Params& p, const bf16_t* __restrict__ Z, const float* __restrict__ CARRY, const bf16_t* __restrict__ CXT, int b, int g, int c, int lane,
                 f32x4 (&acc)[4], float* BUs, unsigned* Sw) {
    const int l15 = lane & 15, quad = lane >> 4;
    bf16x8 bbf[8]; ssm_load_bbf(p, DIR * 24 + g, lane, bbf);
    const float* abar = (const float*)(p.ws + OFF_ABAR) + (size_t)((DIR * 24 + g) * 64 + lane) * 2;
    const float ar = abar[0], ai = abar[1];
    bf16x8 cf[4];
#pragma unroll
    for (int ks = 0; ks < 4; ++ks) cf[ks] = *(const bf16x8*)(CXT + (size_t)((DIR * 24 + g) * 16 + l15) * 128 + ks * 32 + quad * 8);
    const int q = DIR == 0 ? c : (c < 4 ? 3 - c : 135 - c);
    const float* cp = CARRY + ((size_t)(((b * 2 + DIR) * 24 + g) * 132 + q) * 64 + lane) * 2;
    float sr = cp[0], si = cp[1];
#pragma unroll
    for (int subi = 0; subi < 4; ++subi) {
        constexpr bool REV = DIR == 1;
        const int sub = REV ? 3 - subi : subi;
        ssm_sub<REV, true>(Z, b * TPB + c * 64 + sub * 16, g, bbf, ar, ai, sr, si, BUs, Sw, lane);
#pragma unroll
        for (int ks = 0; ks < 4; ++ks) {
            const bf16x8 sf = *(const bf16x8*)((const char*)Sw + l15 * 272 + ks * 64 + quad * 16);
            acc[sub] = MFMA16(cf[ks], sf, acc[sub]);
        }
        WAVE_SYNC
    }
}
DI void phase_ssm3(const Params& p, int l, char* smem) {
    const int lane = TID_ & 63, wave = TID_ >> 6, l15 = lane & 15, quad = lane >> 4;
    const int gw = BID_ * 4 + wave, nw = GDIM_ * 4;
    const bf16_t* Z = (const bf16_t*)(p.ws + OFF_Z); const float* CARRY = (const float*)(p.ws + OFF_OS + T_CARRY);
    bf16_t* YG = (bf16_t*)(p.ws + OFF_T + T_YG);
    const bf16_t* CXT = (const bf16_t*)(p.ws + OFF_CXT);
    const float* dvec = p.in[20] + l * 384;
    float* BUs = (float*)smem + wave * (16 * 132);
    unsigned* Sw = (unsigned*)(smem + 4 * 16 * 132 * 4) + wave * (16 * 68);
    for (int item = gw; item < 2 * 24 * 132; item += nw) {
        const int g = item % 24, c = (item / 24) % 132, b = item / (24 * 132);
        f32x4 acc[4];
#pragma unroll
        for (int i = 0; i < 4; ++i) acc[i] = (f32x4){0.f, 0.f, 0.f, 0.f};
        ssm3_dir<0>(p, Z, CARRY, CXT, b, g, c, lane, acc, BUs, Sw);
        ssm3_dir<1>(p, Z, CARRY, CXT, b, g, c, lane, acc, BUs, Sw);
#pragma unroll
        for (int sub = 0; sub < 4; ++sub) {
            const int row = b * TPB + c * 64 + sub * 16 + l15, ch = g * 16 + quad * 4;
            const uint2 zw = *(const uint2*)(Z + (size_t)row * 1440 + 1056 + ch);
            const f32x4 d = *(const f32x4*)(dvec + ch);
            float y[4] = {acc[sub][0] + d[0] * bflo(zw.x), acc[sub][1] + d[1] * bfhi(zw.x), acc[sub][2] + d[2] * bflo(zw.y), acc[sub][3] + d[3] * bfhi(zw.y)};
#pragma unroll
            for (int j = 0; j < 4; ++j) {
                const float x = y[j], inner = 0.7978845608028654f * (x + 0.044715f * x * x * x);
                const float th = 1.f - 2.f / (__expf(2.f * inner) + 1.f);
                y[j] = 0.5f * x * (1.f + th);
            }
            st_bf4(YG + (size_t)row * 384 + ch, y[0], y[1], y[2], y[3]);
        }
    }
}

DI void run_phase(const Params& p, int ph, char* smem, char* smem8) {
    if (ph == NPH - 1) { phase_final(p); return; }
    const int l = ph / NPH_LAYER;
#ifdef PH_ONLY
    const int k = PH_ONLY; if (ph % NPH_LAYER != PH_ONLY) return;
#else
    const int k = ph % NPH_LAYER;
#endif
#ifdef PH_SKIP
    if (k == PH_SKIP) return;
#endif
#ifdef PH_SKIP2
    if (k == PH_SKIP2) return;
#endif
    switch (k) {
        case 0: phase_prep(p, l, smem); break;
        case 1: phase_norm(p, l, 0); break;
        case 2: phase_gemm_z(p, smem8); break;
        case 3: phase_znorm(p, l); break;
        case 4: phase_gemm_qkv(p, smem); break;
        case 5: phase_four1(p, l, smem); phase_ssm1(p, smem); break;
        case 6: phase_ssm2(p); phase_four2(p, l, smem); break;
        case 7: phase_ssm3(p, l, smem); __syncthreads(); phase_attn(p, l, smem); break;
        case 8: phase_gemm_glu(p, l, smem); break;
        case 9: phase_merge(p, l, smem, smem8); break;
        case 10: phase_gemm_res(p, l, 0, smem, smem8); break;
        case 11: phase_norm(p, l, 1); break;
        case 12: phase_mlp1(p, l, smem, smem8); break;
        default: phase_gemm_res(p, l, 1, smem, smem8); break;
    }
}

#define XB_TMO      128
#define XB_XCNT(j)  (256  + 64 * (j))
#define XB_XSUB(j)  (1280 + 64 * (j))
#define XB_XGEN(j)  (2304 + 64 * (j))
#define XB_TOP      3328
#define XB_TOPGEN   3392
#define XCD_BAR_WORDS 3456
#define XB_SPIN_CAP (1u << 22)
#define LAS __attribute__((address_space(3)))
DI unsigned xb_ld(unsigned* p) { return __hip_atomic_load(p, __ATOMIC_RELAXED, __HIP_MEMORY_SCOPE_AGENT); }
DI unsigned xb_add(unsigned* p, unsigned v) { return __hip_atomic_fetch_add(p, v, __ATOMIC_RELAXED, __HIP_MEMORY_SCOPE_AGENT); }
DI unsigned xb_xcc_id() { return (unsigned)__builtin_amdgcn_s_getreg((3 << 11) | 20) & 0xFu; }
#define XB_SPIN(cond, bar) do { unsigned _sp = 0; while (cond) { __builtin_amdgcn_s_sleep(1); \
    if ((++_sp & 255u) == 0u) { if (xb_ld(&(bar)[XB_TMO])) break; if (_sp > XB_SPIN_CAP) { atomicAdd(&(bar)[XB_TMO], 1u); break; } } } } while (0)
struct XcdBarrier { unsigned* bar; unsigned x; volatile LAS unsigned* st; };
DI XcdBarrier xcd_barrier_post(unsigned* bar, volatile LAS unsigned* st) {
    XcdBarrier b; b.bar = bar; b.x = xb_xcc_id(); b.st = st;
    if (threadIdx.x == 0) (void)xb_add(&bar[XB_XCNT(b.x)], 1u);
    return b;
}
DI void xcd_barrier_complete(unsigned* bar, unsigned x, unsigned& nloc, unsigned& nx) {
    const unsigned G = gridDim.x * gridDim.y * gridDim.z;
    unsigned sum, cnt, mine, sp = 0u;
    for (;;) {
        sum = 0u; cnt = 0u; mine = 0u;
#pragma unroll
        for (unsigned j = 0; j < 16; ++j) { const unsigned c = xb_ld(&bar[XB_XCNT(j)]); sum += c; cnt += (c > 0u) ? 1u : 0u; mine = (j == x) ? c : mine; }
        if (sum == G) break;
        __builtin_amdgcn_s_sleep(1);
        if ((++sp & 255u) == 0u) { if (xb_ld(&bar[XB_TMO])) break; if (sp > XB_SPIN_CAP) { atomicAdd(&bar[XB_TMO], 1u); break; } }
    }
    nloc = mine > 0u ? mine : 1u; nx = cnt > 0u ? cnt : 1u;
}
DI void xcd_barrier(const XcdBarrier& b) {
    asm volatile("s_waitcnt vmcnt(0)" ::: "memory");
    __syncthreads();
    if (threadIdx.x == 0) {
        size_t zb_ = 0; asm volatile("" : "+s"(zb_));
        unsigned* bar = b.bar + zb_;
        __builtin_amdgcn_s_waitcnt(0);
        unsigned nloc = b.st[0], nx = b.st[1];
        if (nloc == 0u) { xcd_barrier_complete(bar, b.x, nloc, nx); b.st[0] = nloc; b.st[1] = nx; }
        const unsigned old = xb_add(&bar[XB_XSUB(b.x)], 1u);
        const unsigned gen = old / nloc;
        if (old + 1u == (gen + 1u) * nloc) {
            __builtin_amdgcn_fence(__ATOMIC_RELEASE, "agent");
            asm volatile("s_waitcnt vmcnt(0)" ::: "memory");
            const unsigned og = xb_add(&bar[XB_TOP], 1u);
            const unsigned tg = og / nx;
            if (og + 1u == (tg + 1u) * nx) xb_add(&bar[XB_TOPGEN], 1u);
            else XB_SPIN(xb_ld(&bar[XB_TOPGEN]) == tg, bar);
            __builtin_amdgcn_fence(__ATOMIC_ACQUIRE, "agent");
            xb_add(&bar[XB_XGEN(b.x)], 1u);
            asm volatile("s_waitcnt vmcnt(0)" ::: "memory");
        } else {
            XB_SPIN(xb_ld(&bar[XB_XGEN(b.x)]) == gen, bar);
            __builtin_amdgcn_fence(__ATOMIC_ACQUIRE, "agent");
            asm volatile("s_waitcnt vmcnt(0)" ::: "memory");
        }
    }
    __syncthreads();
}
__global__ void __launch_bounds__(512, 2) mk_fwd(Params p) {
    __shared__ __attribute__((aligned(16))) char smem[SMEM_BYTES];
    __shared__ uint4 xb_words;
    if (threadIdx.x == 0) xb_words = make_uint4(0u, 0u, 0u, 0u);
    __syncthreads();
    XcdBarrier xb = xcd_barrier_post((unsigned*)(p.ws + OFF_BAR), (volatile LAS unsigned*)&xb_words);
    for (int ph = p.lo; ph < p.hi; ++ph) {
        size_t zoff_ = 0; asm volatile("" : "+s"(zoff_));
        Params q = p; q.ws = p.ws + zoff_; q.out = p.out + zoff_;
        run_phase(q, ph, smem + HALF_ * SMEM_HALF, smem);
        if (ph + 1 < p.hi) {
            if (p.hi < p.lo) cg::this_grid().sync();
            else xcd_barrier(xb);
        }
    }
}

extern "C" void kernel_launch(void* const* d_in, const int* in_sizes, int n_in, void* d_out, int out_size, void* d_ws, size_t ws_size, hipStream_t stream) {
    static int grid_blocks = 0;
    if (!grid_blocks) {
        int dev = 0, cus = 0, per_cu = 0;
        hipGetDevice(&dev);
        hipDeviceGetAttribute(&cus, hipDeviceAttributeMultiprocessorCount, dev);
        hipOccupancyMaxActiveBlocksPerMultiprocessor(&per_cu, (const void*)mk_fwd, 512, 0);
        if (per_cu > 1) per_cu = 1;
        if (per_cu < 1) per_cu = 1;
        grid_blocks = cus * per_cu;
    }
    Params p{};
    for (int i = 0; i < 32; ++i) p.in[i] = (const float*)d_in[i];
    p.out = (float*)d_out; p.ws = (char*)d_ws;
#if MULTI_LAUNCH
    for (int ph = 0; ph < NPH; ++ph) {
        p.lo = ph; p.hi = ph + 1;
        hipLaunchKernelGGL(mk_fwd, dim3(grid_blocks), dim3(512), 0, stream, p);
    }
#else
    p.lo = 0; p.hi = NPH;
    hipMemsetAsync((char*)d_ws + OFF_BAR, 0, 16384, stream);
    void* args[] = {&p};
    hipError_t e = hipLaunchCooperativeKernel((const void*)mk_fwd, dim3(grid_blocks), dim3(512), args, 0, stream);
    if (e != hipSuccess) fprintf(stderr, "cooperative launch failed: %s (grid %d)\n", hipGetErrorString(e), grid_blocks);
#endif
}
```
